# Optimizing an MI355X kernel written in HIP

```python
import jax, jax.numpy as jnp
from jax import lax
import numpy as np

D_MODEL = 1024
BATCH = 8
SEQ = 2048
DEPTH = 4
DEC_BATCH = 32
DEC_SEQ = 32
PAST_LEN = 1024

CHUNK = 64
WINDOW = 128
WIN_CHUNKS = WINDOW // CHUNK
HEAD_DIM = 64
N_HEADS = D_MODEL // HEAD_DIM
N_KV_HEADS = 4
GROUP = N_HEADS // N_KV_HEADS
Q_DIM = N_HEADS * HEAD_DIM
KV_DIM = N_KV_HEADS * HEAD_DIM
CONV_DIM = D_MODEL
CONV_WIDTH = 3
N_MEM = 256
MEM_HEADS = 4
MEM_HEAD_DIM = 64
MEM_DIM = MEM_HEADS * MEM_HEAD_DIM
D_FF = 4 * D_MODEL
EPS = 1e-6
ATTN_SCALE = HEAD_DIM ** -0.5
MEM_SCALE = MEM_HEAD_DIM ** -0.5
IN_COLS = Q_DIM + 2 * KV_DIM + 3 * CONV_DIM + 2 * D_MODEL
SPLITS = (Q_DIM, Q_DIM + KV_DIM, Q_DIM + 2 * KV_DIM, Q_DIM + 2 * KV_DIM + CONV_DIM,
          Q_DIM + 2 * KV_DIM + 2 * CONV_DIM, Q_DIM + 2 * KV_DIM + 3 * CONV_DIM,
          Q_DIM + 2 * KV_DIM + 3 * CONV_DIM + D_MODEL)

kernel_name = 'hybrid_chunk_stream_swa_sink_shortconv_step'


def rms_norm(x, g):
    xf = x.astype(jnp.float32)
    y = xf * lax.rsqrt(jnp.mean(xf * xf, axis=-1, keepdims=True) + EPS)
    return (y * g.astype(jnp.float32)).astype(x.dtype)


def alibi_slopes():
    return jnp.exp2(-8.0 * jnp.arange(1, N_HEADS + 1, dtype=jnp.float32) / N_HEADS)


def sink_softmax(s, sink):
    m = jnp.maximum(jnp.max(s, axis=-1, keepdims=True), sink)
    p = jnp.exp(s - m)
    return p / (jnp.sum(p, axis=-1, keepdims=True) + jnp.exp(sink - m))


def window_attn_prompt(q, k, v, sink):
    B, S = q.shape[0], q.shape[1]
    nb = S // CHUNK
    J = (WIN_CHUNKS + 1) * CHUNK
    pad = ((0, 0), (WIN_CHUNKS * CHUNK, 0), (0, 0), (0, 0))
    kp = jnp.pad(k, pad).reshape(B, nb + WIN_CHUNKS, CHUNK, N_KV_HEADS, HEAD_DIM)
    vp = jnp.pad(v, pad).reshape(B, nb + WIN_CHUNKS, CHUNK, N_KV_HEADS, HEAD_DIM)
    kb = jnp.concatenate([kp[:, j:j + nb] for j in range(WIN_CHUNKS + 1)], axis=2)
    vb = jnp.concatenate([vp[:, j:j + nb] for j in range(WIN_CHUNKS + 1)], axis=2)
    qb = q.reshape(B, nb, CHUNK, N_KV_HEADS, GROUP, HEAD_DIM)
    s = jnp.einsum('bnqkgd,bnjkd->bnkgqj', qb, kb, preferred_element_type=jnp.float32) * ATTN_SCALE
    qpos = jnp.arange(S, dtype=jnp.int32).reshape(nb, CHUNK)
    kpos = (jnp.arange(nb, dtype=jnp.int32)[:, None] - WIN_CHUNKS) * CHUNK + jnp.arange(J, dtype=jnp.int32)[None, :]
    dist = jnp.abs(qpos[:, :, None] - kpos[:, None, :]).astype(jnp.float32)
    slopes = alibi_slopes().reshape(N_KV_HEADS, GROUP)
    bias = -slopes[None, None, :, :, None, None] * dist[None, :, None, None, :, :]
    valid = (kpos >= 0)[None, :, None, None, None, :]
    s = jnp.where(valid, s + bias, jnp.finfo(jnp.float32).min)
    sk = sink.astype(jnp.float32).reshape(N_KV_HEADS, GROUP)[None, None, :, :, None, None]
    p = sink_softmax(s, sk)
    o = jnp.einsum('bnkgqj,bnjkd->bnqkgd', p.astype(v.dtype), vb)
    return o.reshape(B, S, Q_DIM)


def window_attn_sample(q, k_new, v_new, k_cache, v_cache, sink):
    Bd, n = q.shape[0], q.shape[1]
    rows = k_cache.shape[1]
    kk = jnp.concatenate([k_cache, k_new], axis=1)
    vv = jnp.concatenate([v_cache, v_new], axis=1)
    qg = q.reshape(Bd, n, N_KV_HEADS, GROUP, HEAD_DIM)
    s = jnp.einsum('bqkgd,bjkd->bkgqj', qg, kk, preferred_element_type=jnp.float32) * ATTN_SCALE
    qpos = PAST_LEN + jnp.arange(n, dtype=jnp.int32)
    kpos = PAST_LEN - rows + jnp.arange(rows + n, dtype=jnp.int32)
    dist = jnp.abs(qpos[:, None] - kpos[None, :]).astype(jnp.float32)
    slopes = alibi_slopes().reshape(N_KV_HEADS, GROUP)
    s = s - slopes[None, :, :, None, None] * dist[None, None, None]
    sk = sink.astype(jnp.float32).reshape(N_KV_HEADS, GROUP)[None, :, :, None, None]
    p = sink_softmax(s, sk)
    o = jnp.einsum('bkgqj,bjkd->bqkgd', p.astype(vv.dtype), vv)
    return o.reshape(Bd, n, Q_DIM)


def memory_kv(mem, g_mem, w_ckv):
    kv = rms_norm(mem, g_mem) @ w_ckv
    mk, mv = jnp.split(kv, 2, axis=-1)
    B = mem.shape[0]
    return (mk.reshape(B, N_MEM, MEM_HEADS, MEM_HEAD_DIM), mv.reshape(B, N_MEM, MEM_HEADS, MEM_HEAD_DIM))


def trunk_layer(x, attn_core, conv_left, mem_k, mem_v, g_mix, w_in, conv_w, w_attn_out, w_conv_out,
                w_mix_out, g_cross, w_cq, w_co, g_mlp, w_up, w_down):
    B, n = x.shape[0], x.shape[1]
    h = rms_norm(x, g_mix)
    z = h @ w_in
    q, k, v, ch, cb, cc, ga, gb = jnp.split(z, SPLITS, axis=-1)
    q = q.reshape(B, n, N_HEADS, HEAD_DIM)
    k = k.reshape(B, n, N_KV_HEADS, HEAD_DIM)
    v = v.reshape(B, n, N_KV_HEADS, HEAD_DIM)
    a = attn_core(q, k, v) @ w_attn_out
    u = cc * ch
    up = jnp.concatenate([conv_left, u], axis=1)
    conv = up[:, 0:n] * conv_w[0]
    for j in range(1, CONV_WIDTH):
        conv = conv + up[:, j:j + n] * conv_w[j]
    bo = (cb * conv) @ w_conv_out
    x = x + (jax.nn.sigmoid(ga) * a + jax.nn.sigmoid(gb) * bo) @ w_mix_out
    hc = rms_norm(x, g_cross)
    cq = (hc @ w_cq).reshape(B, n, MEM_HEADS, MEM_HEAD_DIM)
    s = jnp.einsum('bqhd,bmhd->bhqm', cq, mem_k, preferred_element_type=jnp.float32) * MEM_SCALE
    p = jax.nn.softmax(s, axis=-1)
    co = jnp.einsum('bhqm,bmhd->bqhd', p.astype(mem_v.dtype), mem_v).reshape(B, n, MEM_DIM)
    x = x + co @ w_co
    hm = rms_norm(x, g_mlp)
    x = x + jnp.square(jax.nn.relu(hm @ w_up)) @ w_down
    return x, k, v, up[:, -(CONV_WIDTH - 1):]


def setup_inputs(seed: int = 0) -> dict:
    key = jax.random.key(seed)
    ks = jax.random.split(key, 24)
    f32 = jnp.float32
    win_rows = min(WINDOW, PAST_LEN)

    def nrm(k, shape, scale):
        return jax.random.normal(k, shape, f32) * scale

    def gain(k, shape):
        return 1.0 + 0.05 * jax.random.normal(k, shape, f32)

    return {
        'x_prompt': nrm(ks[0], (BATCH, SEQ, D_MODEL), 1.0),
        'x_sample': nrm(ks[1], (DEC_BATCH, DEC_SEQ, D_MODEL), 1.0),
        'mem_prompt': nrm(ks[2], (BATCH, N_MEM, D_MODEL), 1.0),
        'cache_attn_k': nrm(ks[3], (DEPTH, DEC_BATCH, win_rows, N_KV_HEADS, HEAD_DIM), 1.0),
        'cache_attn_v': nrm(ks[4], (DEPTH, DEC_BATCH, win_rows, N_KV_HEADS, HEAD_DIM), 1.0),
        'state_conv': nrm(ks[5], (DEPTH, DEC_BATCH, CONV_WIDTH - 1, CONV_DIM), 1.0),
        'cache_mem_k': nrm(ks[6], (DEPTH, DEC_BATCH, N_MEM, MEM_HEADS, MEM_HEAD_DIM), 1.0),
        'cache_mem_v': nrm(ks[7], (DEPTH, DEC_BATCH, N_MEM, MEM_HEADS, MEM_HEAD_DIM), 1.0),
        'norm_mix_g': gain(ks[8], (DEPTH, D_MODEL)),
        'w_in': nrm(ks[9], (DEPTH, D_MODEL, IN_COLS), D_MODEL ** -0.5),
        'conv_w': nrm(ks[10], (DEPTH, CONV_WIDTH, CONV_DIM), CONV_WIDTH ** -0.5),
        'attn_sink': nrm(ks[11], (DEPTH, N_HEADS), 0.5),
        'w_attn_out': nrm(ks[12], (DEPTH, Q_DIM, D_MODEL), Q_DIM ** -0.5),
        'w_conv_out': nrm(ks[13], (DEPTH, CONV_DIM, D_MODEL), CONV_DIM ** -0.5),
        'w_mix_out': nrm(ks[14], (DEPTH, D_MODEL, D_MODEL), D_MODEL ** -0.5),
        'norm_cross_g': gain(ks[15], (DEPTH, D_MODEL)),
        'norm_mem_g': gain(ks[16], (DEPTH, D_MODEL)),
        'w_cq': nrm(ks[17], (DEPTH, D_MODEL, MEM_DIM), D_MODEL ** -0.5),
        'w_ckv': nrm(ks[18], (DEPTH, D_MODEL, 2 * MEM_DIM), D_MODEL ** -0.5),
        'w_co': nrm(ks[19], (DEPTH, MEM_DIM, D_MODEL), MEM_DIM ** -0.5),
        'norm_mlp_g': gain(ks[20], (DEPTH, D_MODEL)),
        'w_up': nrm(ks[21], (DEPTH, D_MODEL, D_FF), D_MODEL ** -0.5),
        'w_down': nrm(ks[22], (DEPTH, D_FF, D_MODEL), 0.5 * D_FF ** -0.5),
        'norm_final_g': gain(ks[23], (D_MODEL,)),
    }


def reference(x_prompt, x_sample, mem_prompt, cache_attn_k, cache_attn_v, state_conv, cache_mem_k, cache_mem_v,
              norm_mix_g, w_in, conv_w, attn_sink, w_attn_out, w_conv_out, w_mix_out, norm_cross_g, norm_mem_g,
              w_cq, w_ckv, w_co, norm_mlp_g, w_up, w_down, norm_final_g):
    xp = x_prompt
    xs = x_sample
    prompt_rows = min(WINDOW, xp.shape[1])
    kp_l, vp_l, cp_l, mkp_l, mvp_l = [], [], [], [], []
    ks_l, vs_l, cs_l = [], [], []
    for l in range(DEPTH):
        sink = attn_sink[l]
        shared = (norm_mix_g[l], w_in[l], conv_w[l], w_attn_out[l], w_conv_out[l], w_mix_out[l],
                  norm_cross_g[l], w_cq[l], w_co[l], norm_mlp_g[l], w_up[l], w_down[l])
        mk, mv = memory_kv(mem_prompt, norm_mem_g[l], w_ckv[l])
        zero_left = jnp.zeros((xp.shape[0], CONV_WIDTH - 1, CONV_DIM), xp.dtype)
        xp, kp, vp, cpst = trunk_layer(xp, lambda q, k, v: window_attn_prompt(q, k, v, sink),
                                       zero_left, mk, mv, *shared)
        kp_l.append(kp[:, -prompt_rows:])
        vp_l.append(vp[:, -prompt_rows:])
        cp_l.append(cpst)
        mkp_l.append(mk)
        mvp_l.append(mv)
        kc, vc = cache_attn_k[l], cache_attn_v[l]
        xs, kn, vn, csst = trunk_layer(xs, lambda q, k, v: window_attn_sample(q, k, v, kc, vc, sink),
                                       state_conv[l], cache_mem_k[l], cache_mem_v[l], *shared)
        ks_l.append(kn)
        vs_l.append(vn)
        cs_l.append(csst)
    y_prompt = rms_norm(xp, norm_final_g)
    y_sample = rms_norm(xs, norm_final_g)
    return (y_prompt, y_sample,
            jnp.stack(kp_l), jnp.stack(vp_l), jnp.stack(cp_l), jnp.stack(mkp_l), jnp.stack(mvp_l),
            jnp.stack(ks_l), jnp.stack(vs_l), jnp.stack(cs_l))
```

```cpp
#include <hip/hip_runtime.h>
#include <hip/hip_cooperative_groups.h>
#include <cstdio>
#include <cstdint>
namespace cg = cooperative_groups;
namespace pg8 {
#define PG8_LAS __attribute__((address_space(3)))
typedef unsigned short bf16_t;
typedef short bf16x8 __attribute__((ext_vector_type(8)));
typedef float f32x4 __attribute__((ext_vector_type(4)));
typedef unsigned u32x4 __attribute__((ext_vector_type(4)));
constexpr int BM = 256, BK = 64, HALF = 128, HTB = HALF * BK * 2  , STAGE_BYTES = 8 * HTB, NXCD = 8, WGM = 8;

__host__ __device__ __forceinline__ int lds_byte(int r, int c) { const int st = (r >> 4) * 2 + (c >> 5), rr = r & 15, cc = c & 31, ob = rr * 64 + cc * 2; return st * 1024 + (ob ^ (((ob >> 9) & 1) << 5)); }
__host__ __device__ __forceinline__ void stage_rc(int b, int& R, int& C) { const int st = b / 1024, sb = b % 1024, swz = sb ^ (((sb >> 9) & 1) << 5); R = (st >> 1) * 16 + swz / 64; C = (st & 1) * 32 + (swz % 64) / 2; }
__host__ __device__ __forceinline__ int perm32(int rho) { const int n = rho >> 4, i = rho & 15; return 8 * (i >> 2) + 4 * n + (i & 3); }

struct Unit { int pm, pn; };
struct Gemm { const bf16_t* A; const bf16_t* Bt; int M, N, K; };

struct StaticOrder {
    int nM, nN, nwg, G, c;
    __host__ __device__ void init(int M, int N, int G_, int c_) { nM = M / BM; nN = N / BM; nwg = nM * nN; G = G_; c = c_; }
    __host__ __device__ bool next(int i, Unit& u) const {
        const long L = (long)i * G + c; if (L >= nwg) return false;
        int wgid = (int)L; { const int q = nwg / NXCD, r = nwg % NXCD, xcd = wgid % NXCD, off = wgid / NXCD; wgid = (xcd < r ? xcd * (q + 1) : r * (q + 1) + (xcd - r) * q) + off; }
        const int nig = WGM * nN, gid = wgid / nig, fm = gid * WGM, gsz = (nM - fm) < WGM ? (nM - fm) : WGM;
        u.pm = fm + ((wgid % nig) % gsz); u.pn = (wgid % nig) / gsz; return true;
    }
    __device__ __forceinline__ void a_ready(const Unit&) const {}
    __device__ __forceinline__ void done(const Unit&) const {}
};

template <class Epi, class Sched, bool ALIGN_EPI = false, bool SP2 = false>
__device__ __forceinline__ void gemm_phase(PG8_LAS unsigned char* lds, const Gemm g, const Sched& S, const Epi& E) {
    int tid_l = threadIdx.x; asm volatile("" : "+v"(tid_l)); const int tid = tid_l, wid = __builtin_amdgcn_readfirstlane(tid >> 6), lane = tid & 63, wr = wid >> 2, wc = wid & 3, fr = lane & 15, fq = lane >> 4;
    const int K = g.K, nt = K / BK;
    unsigned voffA[2], voffB[2];
#pragma unroll
    for (int i = 0; i < 2; ++i) { int R, C; stage_rc(tid * 16 + i * 8192, R, C); const int Rb = Epi::PERM ? ((R & ~31) + perm32(R & 31)) : R;
        voffA[i] = (unsigned)(R * K + C) * 2u; voffB[i] = (unsigned)(Rb * K + C) * 2u; }
    const size_t kstep = (size_t)(BK * 2);
    const size_t hstep = (size_t)HALF * K * 2;
    const size_t tstep = 2 * hstep;
    const unsigned ldsw = (unsigned)wid * 1024u;
    const int aoff = lds_byte(wr * 64 + fr, fq * 8), boff = lds_byte(wc * 32 + fr, fq * 8);
#define PG8_SA(b, h) (((b) * 2 + (h)) * HTB)
#define PG8_SB(b, h) ((4 + (b) * 2 + (h)) * HTB)
#define PG8_STAGE(bufoff, gbase, voff) do { _Pragma("unroll") for (int _i = 0; _i < 2; ++_i) \
        __builtin_amdgcn_global_load_lds((const unsigned*)((const char*)(gbase) + (voff)[_i]), (PG8_LAS unsigned*)(lds + (bufoff) + ldsw + _i * 8192), 16, 0, 0); } while (0)
#define PG8_LDA(dst, b, h) do { _Pragma("unroll") for (int m = 0; m < 4; ++m) _Pragma("unroll") for (int k = 0; k < 2; ++k) dst[m][k] = *(const PG8_LAS bf16x8*)(lds + PG8_SA(b, h) + aoff + m * 2048 + k * 1024); } while (0)
#define PG8_LDB(dst, b, h) do { _Pragma("unroll") for (int n = 0; n < 2; ++n) _Pragma("unroll") for (int k = 0; k < 2; ++k) dst[n][k] = *(const PG8_LAS bf16x8*)(lds + PG8_SB(b, h) + boff + n * 2048 + k * 1024); } while (0)
#define PG8_MMA(ai, bj, At, Bt) do { __builtin_amdgcn_s_setprio(1); _Pragma("unroll") for (int m = 0; m < 4; ++m) _Pragma("unroll") for (int n = 0; n < 2; ++n) _Pragma("unroll") for (int k = 0; k < 2; ++k) \
        acc[ai][bj][m][n] = __builtin_amdgcn_mfma_f32_16x16x32_bf16(Bt[n][k], At[m][k], acc[ai][bj][m][n], 0, 0, 0); __builtin_amdgcn_s_setprio(0); } while (0)
#define PG8_WAIT_V(n) asm volatile("s_waitcnt vmcnt(" #n ")" ::: "memory")
#define PG8_WAIT_L(n) asm volatile("s_waitcnt lgkmcnt(" #n ")" ::: "memory")
#define PG8_BAR __builtin_amdgcn_s_barrier()
#define PG8_SCHED __builtin_amdgcn_sched_barrier(0)
    Unit cur, nxt; int ui = 0;
    if (!S.next(0, cur)) return;
    f32x4 acc[2][2][4][2];
#pragma unroll
    for (int a = 0; a < 2; ++a)
#pragma unroll
        for (int b = 0; b < 2; ++b)
#pragma unroll
            for (int m = 0; m < 4; ++m)
#pragma unroll
                for (int n = 0; n < 2; ++n) acc[a][b][m][n] = (f32x4){0.f, 0.f, 0.f, 0.f};
    bf16x8 At[4][2], B0[2][2], B1[2][2];
    const char* cA = (const char*)g.A + (size_t)cur.pm * tstep; const char* cB = (const char*)g.Bt + (size_t)cur.pn * tstep;
    S.a_ready(cur);
    if constexpr (SP2) {
        PG8_STAGE(PG8_SB(0, 0), cB, voffB); PG8_STAGE(PG8_SB(0, 1), cB + hstep, voffB); PG8_STAGE(PG8_SA(0, 0), cA, voffA); PG8_STAGE(PG8_SA(0, 1), cA + hstep, voffA);
        if (wr == 1) PG8_BAR;
        PG8_WAIT_V(2); PG8_BAR;
        PG8_STAGE(PG8_SB(1, 0), cB + kstep, voffB); PG8_STAGE(PG8_SA(1, 0), cA + kstep, voffA); PG8_STAGE(PG8_SB(1, 1), cB + hstep + kstep, voffB);
        PG8_WAIT_V(6); PG8_BAR;
    } else {
        PG8_STAGE(PG8_SB(0, 0), cB, voffB); PG8_STAGE(PG8_SA(0, 0), cA, voffA); PG8_STAGE(PG8_SB(0, 1), cB + hstep, voffB); PG8_STAGE(PG8_SA(0, 1), cA + hstep, voffA);
        if (wr == 1) PG8_BAR;
        PG8_WAIT_V(4); PG8_BAR;
        PG8_STAGE(PG8_SB(1, 0), cB + kstep, voffB); PG8_STAGE(PG8_SA(1, 0), cA + kstep, voffA); PG8_STAGE(PG8_SB(1, 1), cB + hstep + kstep, voffB);
        PG8_WAIT_V(6); PG8_BAR;
    }
    for (;;) {
        const bool has_next = S.next(ui + 1, nxt);
        const char* nA = has_next ? (const char*)g.A + (size_t)nxt.pm * tstep : cA; const char* nB = has_next ? (const char*)g.Bt + (size_t)nxt.pn * tstep : cB;
        for (int t = 0; t < nt; t += 2) {
            const bool last = (t == nt - 2);
            const char* a1 = cA + (size_t)(t + 1) * kstep;
            const char* a2 = last ? nA : cA + (size_t)(t + 2) * kstep; const char* b2 = last ? nB : cB + (size_t)(t + 2) * kstep;
            const char* a3 = a2 + kstep; const char* b3 = b2 + kstep;
            if (last && has_next) S.a_ready(nxt);
            if constexpr (SP2) {
            PG8_LDB(B0, 0, 0); PG8_LDB(B1, 0, 1); PG8_SCHED; PG8_LDA(At, 0, 0); PG8_STAGE(PG8_SA(1, 1), a1 + hstep, voffA);
            PG8_WAIT_V(8); PG8_WAIT_L(0); PG8_BAR; PG8_MMA(0, 0, At, B0); PG8_MMA(0, 1, At, B1); PG8_BAR; PG8_SCHED;
            PG8_LDA(At, 0, 1); PG8_STAGE(PG8_SB(0, 0), b2, voffB); PG8_STAGE(PG8_SB(0, 1), b2 + hstep, voffB); PG8_STAGE(PG8_SA(0, 0), a2, voffA);
            PG8_WAIT_V(8); PG8_WAIT_L(0); PG8_BAR; PG8_MMA(1, 0, At, B0); PG8_MMA(1, 1, At, B1); PG8_BAR; PG8_SCHED;
            PG8_LDB(B0, 1, 0); PG8_LDB(B1, 1, 1); PG8_SCHED; PG8_LDA(At, 1, 0); PG8_STAGE(PG8_SA(0, 1), a2 + hstep, voffA);
            PG8_WAIT_V(8); PG8_WAIT_L(0); PG8_BAR; PG8_MMA(0, 0, At, B0); PG8_MMA(0, 1, At, B1); PG8_BAR; PG8_SCHED;
            PG8_LDA(At, 1, 1); PG8_STAGE(PG8_SB(1, 0), b3, voffB); PG8_STAGE(PG8_SB(1, 1), b3 + hstep, voffB); PG8_STAGE(PG8_SA(1, 0), a3, voffA);
            PG8_WAIT_V(8); PG8_WAIT_L(0); PG8_BAR; PG8_MMA(1, 0, At, B0); PG8_MMA(1, 1, At, B1); PG8_BAR; PG8_SCHED;
            } else {
            PG8_LDB(B0, 0, 0); PG8_SCHED; PG8_LDA(At, 0, 0); PG8_STAGE(PG8_SA(1, 1), a1 + hstep, voffA);
            PG8_WAIT_L(8); PG8_BAR; PG8_WAIT_L(0); PG8_MMA(0, 0, At, B0); PG8_BAR; PG8_SCHED;
            PG8_LDB(B1, 0, 1); PG8_STAGE(PG8_SB(0, 0), b2, voffB);
            PG8_BAR; PG8_WAIT_L(0); PG8_MMA(0, 1, At, B1); PG8_BAR;
            PG8_LDA(At, 0, 1); PG8_STAGE(PG8_SA(0, 0), a2, voffA);
            PG8_BAR; PG8_WAIT_L(0); PG8_MMA(1, 0, At, B0); PG8_BAR; PG8_SCHED;
            PG8_STAGE(PG8_SB(0, 1), b2 + hstep, voffB);
            PG8_WAIT_V(6); PG8_BAR; PG8_MMA(1, 1, At, B1); PG8_BAR;
            PG8_LDB(B0, 1, 0); PG8_SCHED; PG8_LDA(At, 1, 0); PG8_STAGE(PG8_SA(0, 1), a2 + hstep, voffA);
            PG8_WAIT_L(8); PG8_BAR; PG8_WAIT_L(0); PG8_MMA(0, 0, At, B0); PG8_BAR; PG8_SCHED;
            PG8_LDB(B1, 1, 1); PG8_STAGE(PG8_SB(1, 0), b3, voffB);
            PG8_BAR; PG8_WAIT_L(0); PG8_MMA(0, 1, At, B1); PG8_BAR;
            PG8_LDA(At, 1, 1); PG8_STAGE(PG8_SA(1, 0), a3, voffA);
            PG8_BAR; PG8_WAIT_L(0); PG8_MMA(1, 0, At, B0); PG8_BAR; PG8_SCHED;
            PG8_STAGE(PG8_SB(1, 1), b3 + hstep, voffB);
            PG8_WAIT_V(6); PG8_BAR; PG8_MMA(1, 1, At, B1); PG8_BAR;
            }
        }
        if constexpr (ALIGN_EPI) { if (wr == 0) PG8_BAR; }
        if constexpr (!Epi::AFTER_DRAIN) { E(acc, cur, wr, wc, fr, fq); S.done(cur); }
        if (!has_next) break;
#pragma unroll
        for (int a = 0; a < 2; ++a)
#pragma unroll
            for (int b = 0; b < 2; ++b)
#pragma unroll
                for (int m = 0; m < 4; ++m)
#pragma unroll
                    for (int n = 0; n < 2; ++n) acc[a][b][m][n] = (f32x4){0.f, 0.f, 0.f, 0.f};
        cur = nxt; cA = nA; cB = nB; ++ui;
        if constexpr (ALIGN_EPI) { if (wr == 1) PG8_BAR; }
    }
    PG8_WAIT_V(0);
    if constexpr (!ALIGN_EPI) { if (wr == 0) PG8_BAR; }
    PG8_BAR;
    if constexpr (Epi::AFTER_DRAIN) { E.fused(acc, cur, wr, wc, fr, fq, lds, wid, lane); S.done(cur); }
#undef PG8_SA
#undef PG8_SB
#undef PG8_STAGE
#undef PG8_LDA
#undef PG8_LDB
#undef PG8_MMA
#undef PG8_WAIT_V
#undef PG8_WAIT_L
#undef PG8_BAR
#undef PG8_SCHED
}
}

#define LAS __attribute__((address_space(3)))
typedef unsigned short bf16_t;
typedef short bf16x8 __attribute__((ext_vector_type(8)));
typedef short s16x4 __attribute__((ext_vector_type(4)));
typedef float f32x4 __attribute__((ext_vector_type(4)));
typedef float f32x16 __attribute__((ext_vector_type(16)));
typedef unsigned u32x4 __attribute__((ext_vector_type(4)));
typedef unsigned u32x2 __attribute__((ext_vector_type(2)));
typedef float f32x2_t __attribute__((ext_vector_type(2)));
typedef __bf16 bf16x2_t __attribute__((ext_vector_type(2)));

constexpr int DM = 1024, MP = 16384, MS = 1024, MT = MP + MS, NIN = 6656, FF = 4096, DEPTH = 4;
constexpr int SEQ = 2048, NB = 8, DB = 32, DSQ = 32;
constexpr float EPS = 1e-6f;
constexpr float LOG2E = 1.4426950408889634f;
constexpr size_t MiB = 1u << 20;
constexpr size_t WO_IN = 0, WO_AO = WO_IN + (size_t)NIN * DM, WO_CV = WO_AO + (size_t)DM * DM, WO_MIX = WO_CV + (size_t)DM * DM,
                 WO_CQ = WO_MIX + (size_t)DM * DM, WO_CKV = WO_CQ + (size_t)256 * DM, WO_CO = WO_CKV + (size_t)512 * DM,
                 WO_UP = WO_CO + (size_t)DM * 256, WO_DN = WO_UP + (size_t)FF * DM, W_LAYER = WO_DN + (size_t)DM * FF;
constexpr size_t WS_W = 1 * MiB, WS_XB = 150 * MiB, WS_SSQ = 184 * MiB, WS_MEMN = 186 * MiB, WS_MKV = 190 * MiB, WS_CQ = 198 * MiB, WS_CO = 207 * MiB,
                 WS_ZQ = 216 * MiB, WS_ZKV = 250 * MiB, WS_ZCH = 267 * MiB, WS_ZCB = 301 * MiB, WS_ZCC = 335 * MiB, WS_ZGA = 369 * MiB, WS_ZGB = 403 * MiB, WS_END = 437 * MiB;
constexpr size_t WS_HID = WS_ZQ;
static_assert(WS_W + W_LAYER * 2 * DEPTH <= WS_XB, "weights fit");
static_assert(WS_HID + (size_t)MT * FF * 2 <= WS_ZGA, "hid overlay");
constexpr size_t O_Y = 0, O_KP = 17825792, O_VP = 18874368, O_CP = 19922944, O_MKP = 19988480, O_MVP = 22085632, O_KS = 24182784, O_VS = 25231360, O_CS = 26279936;

__device__ __forceinline__ unsigned cvtpk(float lo, float hi) { f32x2_t v = {lo, hi}; bf16x2_t b = __builtin_convertvector(v, bf16x2_t); return __builtin_bit_cast(unsigned, b); }
__device__ __forceinline__ float bf2f(unsigned short b) { return __uint_as_float(((unsigned)b) << 16); }
__device__ __forceinline__ float bflo(unsigned w) { return __uint_as_float(w << 16); }
__device__ __forceinline__ float bfhi(unsigned w) { return __uint_as_float(w & 0xffff0000u); }
__device__ __forceinline__ float sigmoidf_(float x) { return __builtin_amdgcn_rcpf(1.0f + __builtin_amdgcn_exp2f(-x * LOG2E)); }
__device__ __forceinline__ float wave_sum(float v) {
#pragma unroll
    for (int o = 1; o < 64; o <<= 1) v += __shfl_xor(v, o);
    return v;
}
__device__ __forceinline__ float row_rstd(const float* ssq, int row) {
    const f32x4* p = (const f32x4*)(ssq + (size_t)row * 16);
    const f32x4 a = p[0], b = p[1], c = p[2], d = p[3];
    const float s = ((a[0] + a[1]) + (a[2] + a[3])) + ((b[0] + b[1]) + (b[2] + b[3])) + ((c[0] + c[1]) + (c[2] + c[3])) + ((d[0] + d[1]) + (d[2] + d[3]));
    return rsqrtf(s * (1.0f / DM) + EPS);
}
__device__ __forceinline__ float row_rstd_q(const float* ssq, int row, int fq) {
    const f32x4 a = *(const f32x4*)(ssq + (size_t)row * 16 + fq * 4);
    float s = (a[0] + a[1]) + (a[2] + a[3]);
    s += __shfl_xor(s, 16); s += __shfl_xor(s, 32);
    return rsqrtf(s * (1.0f / DM) + EPS);
}
__device__ __forceinline__ u32x4 pack8(const f32x4 v0, const f32x4 v1) { u32x4 w; w.x = cvtpk(v0[0], v0[1]); w.y = cvtpk(v0[2], v0[3]); w.z = cvtpk(v1[0], v1[1]); w.w = cvtpk(v1[2], v1[3]); return w; }
__device__ __forceinline__ void unpack8(const u32x4 w, f32x4& v0, f32x4& v1) { v0 = (f32x4){bflo(w.x), bfhi(w.x), bflo(w.y), bfhi(w.y)}; v1 = (f32x4){bflo(w.z), bfhi(w.z), bflo(w.w), bfhi(w.w)}; }

typedef f32x4 acc_t[2][2][4][2];
#define EPI_LOOP_ROWS for (int ai = 0; ai < 2; ++ai) _Pragma("unroll") for (int m = 0; m < 4; ++m)

struct EpiZ {
    static constexpr bool PERM = true, AFTER_DRAIN = false;
    bf16_t *zq, *zkv, *zch, *zcb, *zcc, *zga, *zgb; const float* ssq; float *okp, *ovp, *oks, *ovs;
    __device__ __forceinline__ void operator()(const acc_t& acc, const pg8::Unit& u, int wr, int wc, int fr0, int fq0) const {
        int fr = fr0, fq = fq0; asm volatile("" : "+v"(fr), "+v"(fq));
        const int pn = u.pn; bf16_t* base; int ldc, c0;
        if (pn < 4) { base = zq; ldc = 1024; c0 = pn * 256; }
        else if (pn < 6) { base = zkv; ldc = 512; c0 = (pn - 4) * 256; }
        else if (pn < 14) { base = zch; ldc = 1024; c0 = (pn - 6) * 128; }
        else { const int t = (pn - 14) >> 2; base = (bf16_t*)((unsigned char*)zcb + (size_t)t * (WS_ZGA - WS_ZCB) - (t == 2 ? (2 * (WS_ZGA - WS_ZCB) - (WS_ZGB - WS_ZCB)) : 0)); ldc = 1024; c0 = ((pn - 14) & 3) * 256; }
        float* fo = nullptr; int fo_ai_min = 0;
        if (pn == 4 || pn == 5) {
            if (u.pm >= 64) { fo = (pn == 4 ? oks : ovs) + (size_t)(u.pm - 64) * 256 * 256; }
            else if ((u.pm & 7) == 7) { fo = (pn == 4 ? okp : ovp) + (size_t)(u.pm >> 3) * 128 * 256 - 128 * 256; fo_ai_min = 1; }
        }
        const int colw = wc * 32 + 8 * fq;
        float rsv[2][4];
#pragma unroll
        EPI_LOOP_ROWS rsv[ai][m] = row_rstd_q(ssq, u.pm * 256 + ai * 128 + wr * 64 + m * 16 + fr, fq);
#pragma unroll
        EPI_LOOP_ROWS {
            const int rl = ai * 128 + wr * 64 + m * 16 + fr, row = u.pm * 256 + rl;
            const float rs = rsv[ai][m];
            if (pn >= 6 && pn < 14) {
                const float rs2 = rs * rs;
                const f32x4 v0 = acc[ai][0][m][0] * acc[ai][1][m][0] * rs2, v1 = acc[ai][0][m][1] * acc[ai][1][m][1] * rs2;
                *(u32x4*)(base + (size_t)row * ldc + c0 + colw) = pack8(v0, v1);
            } else {
#pragma unroll
            for (int bj = 0; bj < 2; ++bj) {
                const f32x4 v0 = acc[ai][bj][m][0] * rs, v1 = acc[ai][bj][m][1] * rs;
                const int cl = bj * 128 + colw;
                *(u32x4*)(base + (size_t)row * ldc + c0 + cl) = pack8(v0, v1);
                if (fo && ai >= fo_ai_min) { float* p = fo + (size_t)rl * 256 + cl; *(f32x4*)p = v0; *(f32x4*)(p + 4) = v1; }
            }
            }
        }
    }
};
struct EpiGate1 {
    static constexpr bool PERM = true, AFTER_DRAIN = false;
    bf16_t* zga;
    __device__ __forceinline__ void operator()(const acc_t& acc, const pg8::Unit& u, int wr, int wc, int fr0, int fq0) const {
        int fr = fr0, fq = fq0; asm volatile("" : "+v"(fr), "+v"(fq));
        const int colw = u.pn * 256 + wc * 32 + 8 * fq;
#pragma unroll
        for (int ai = 0; ai < 2; ++ai) {
            u32x4 gw[4][2];
#pragma unroll
            for (int m = 0; m < 4; ++m)
#pragma unroll
                for (int bj = 0; bj < 2; ++bj) gw[m][bj] = *(const u32x4*)(zga + (size_t)(u.pm * 256 + ai * 128 + wr * 64 + m * 16 + fr) * 1024 + colw + bj * 128);
#pragma unroll
            for (int m = 0; m < 4; ++m)
#pragma unroll
                for (int bj = 0; bj < 2; ++bj) {
                    f32x4 g0, g1; unpack8(gw[m][bj], g0, g1);
                    f32x4 v0 = acc[ai][bj][m][0], v1 = acc[ai][bj][m][1];
#pragma unroll
                    for (int e = 0; e < 4; ++e) { v0[e] *= sigmoidf_(g0[e]); v1[e] *= sigmoidf_(g1[e]); }
                    *(u32x4*)(zga + (size_t)(u.pm * 256 + ai * 128 + wr * 64 + m * 16 + fr) * 1024 + colw + bj * 128) = pack8(v0, v1);
                }
        }
    }
};
struct EpiGate2 {
    static constexpr bool PERM = true, AFTER_DRAIN = false;
    bf16_t* zga; const bf16_t* zgb;
    __device__ __forceinline__ void operator()(const acc_t& acc, const pg8::Unit& u, int wr, int wc, int fr0, int fq0) const {
        int fr = fr0, fq = fq0; asm volatile("" : "+v"(fr), "+v"(fq));
        const int colw = u.pn * 256 + wc * 32 + 8 * fq;
#pragma unroll
        for (int ai = 0; ai < 2; ++ai) {
            u32x4 tw[4][2], gw[4][2];
#pragma unroll
            for (int m = 0; m < 4; ++m)
#pragma unroll
                for (int bj = 0; bj < 2; ++bj) { const size_t off = (size_t)(u.pm * 256 + ai * 128 + wr * 64 + m * 16 + fr) * 1024 + colw + bj * 128;
                    tw[m][bj] = *(const u32x4*)(zga + off); gw[m][bj] = *(const u32x4*)(zgb + off); }
#pragma unroll
            for (int m = 0; m < 4; ++m)
#pragma unroll
                for (int bj = 0; bj < 2; ++bj) {
                    const size_t off = (size_t)(u.pm * 256 + ai * 128 + wr * 64 + m * 16 + fr) * 1024 + colw + bj * 128;
                    f32x4 t0, t1, g0, g1; unpack8(tw[m][bj], t0, t1); unpack8(gw[m][bj], g0, g1);
                    f32x4 v0 = acc[ai][bj][m][0], v1 = acc[ai][bj][m][1];
#pragma unroll
                    for (int e = 0; e < 4; ++e) { v0[e] = t0[e] + v0[e] * sigmoidf_(g0[e]); v1[e] = t1[e] + v1[e] * sigmoidf_(g1[e]); }
                    *(u32x4*)(zga + off) = pack8(v0, v1);
                }
        }
    }
};
template <bool SCALE> struct EpiResidT {
    static constexpr bool PERM = true, AFTER_DRAIN = false;
    float* x; bf16_t* xb; float* ssq; const float* ssq_in;
    __device__ __forceinline__ void operator()(const acc_t& acc, const pg8::Unit& u, int wr, int wc, int fr0, int fq0) const {
        int fr = fr0, fq = fq0; asm volatile("" : "+v"(fr), "+v"(fq));
        const int colw = u.pn * 256 + wc * 32 + 8 * fq;
#pragma unroll
        for (int ai = 0; ai < 2; ++ai) {
            u32x4 xr[4][2]; float rs2[4];
#pragma unroll
            for (int m = 0; m < 4; ++m) {
                const int row = u.pm * 256 + ai * 128 + wr * 64 + m * 16 + fr;
#pragma unroll
                for (int bj = 0; bj < 2; ++bj) xr[m][bj] = *(const u32x4*)(xb + (size_t)row * 1024 + colw + bj * 128);
                if (SCALE) { const float r_ = row_rstd_q(ssq_in, row, fq); rs2[m] = r_ * r_; } else rs2[m] = 1.f;
            }
#pragma unroll
            for (int m = 0; m < 4; ++m) {
                const int row = u.pm * 256 + ai * 128 + wr * 64 + m * 16 + fr;
                float sq = 0.f;
#pragma unroll
                for (int bj = 0; bj < 2; ++bj) {
                    const size_t off = (size_t)row * 1024 + colw + bj * 128;
                    f32x4 x0, x1; unpack8(xr[m][bj], x0, x1);
                    const f32x4 v0 = SCALE ? x0 + acc[ai][bj][m][0] * rs2[m] : x0 + acc[ai][bj][m][0],
                                v1 = SCALE ? x1 + acc[ai][bj][m][1] * rs2[m] : x1 + acc[ai][bj][m][1];
                    *(u32x4*)(xb + off) = pack8(v0, v1);
                    sq += (v0[0] * v0[0] + v0[1] * v0[1]) + (v0[2] * v0[2] + v0[3] * v0[3]) + (v1[0] * v1[0] + v1[1] * v1[1]) + (v1[2] * v1[2] + v1[3] * v1[3]);
                }
                sq += __shfl_xor(sq, 16); sq += __shfl_xor(sq, 32);
                if (fq == 0) ssq[(size_t)row * 16 + u.pn * 4 + wc] = sq;
            }
        }
    }
};
template <int ACT> struct EpiScale {
    static constexpr bool PERM = true, AFTER_DRAIN = false;
    bf16_t* o; int ldc; const float* ssq;
    __device__ __forceinline__ void operator()(const acc_t& acc, const pg8::Unit& u, int wr, int wc, int fr0, int fq0) const {
        int fr = fr0, fq = fq0; asm volatile("" : "+v"(fr), "+v"(fq));
        const int colw = u.pn * 256 + wc * 32 + 8 * fq;
        float rsv[2][4];
#pragma unroll
        EPI_LOOP_ROWS rsv[ai][m] = row_rstd_q(ssq, u.pm * 256 + ai * 128 + wr * 64 + m * 16 + fr, fq);
#pragma unroll
        EPI_LOOP_ROWS {
            const int row = u.pm * 256 + ai * 128 + wr * 64 + m * 16 + fr;
            const float rs = rsv[ai][m];
#pragma unroll
            for (int bj = 0; bj < 2; ++bj) {
                f32x4 v0 = acc[ai][bj][m][0] * rs, v1 = acc[ai][bj][m][1] * rs;
                if (ACT == 1) {
#pragma unroll
                    for (int e = 0; e < 4; ++e) { const float a = fmaxf(v0[e], 0.f), b = fmaxf(v1[e], 0.f); v0[e] = a * a; v1[e] = b * b; }
                }
                *(u32x4*)(o + (size_t)row * ldc + colw + bj * 128) = pack8(v0, v1);
            }
        }
    }
};
struct EpiRelu2 {
    static constexpr bool PERM = true, AFTER_DRAIN = false;
    bf16_t* o; int ldc;
    __device__ __forceinline__ void operator()(const acc_t& acc, const pg8::Unit& u, int wr, int wc, int fr0, int fq0) const {
        int fr = fr0, fq = fq0; asm volatile("" : "+v"(fr), "+v"(fq));
        const int colw = u.pn * 256 + wc * 32 + 8 * fq;
#pragma unroll
        EPI_LOOP_ROWS {
            const int row = u.pm * 256 + ai * 128 + wr * 64 + m * 16 + fr;
#pragma unroll
            for (int bj = 0; bj < 2; ++bj) {
                f32x4 v0 = acc[ai][bj][m][0], v1 = acc[ai][bj][m][1];
#pragma unroll
                for (int e = 0; e < 4; ++e) { const float a = fmaxf(v0[e], 0.f), b = fmaxf(v1[e], 0.f); v0[e] = a * a; v1[e] = b * b; }
                *(u32x4*)(o + (size_t)row * ldc + colw + bj * 128) = pack8(v0, v1);
            }
        }
    }
};
struct EpiMemKV {
    static constexpr bool PERM = true, AFTER_DRAIN = false;
    bf16_t* mkv; float *ok, *ov;
    __device__ __forceinline__ void operator()(const acc_t& acc, const pg8::Unit& u, int wr, int wc, int fr0, int fq0) const {
        int fr = fr0, fq = fq0; asm volatile("" : "+v"(fr), "+v"(fq));
        const int colw = wc * 32 + 8 * fq; float* fo = u.pn == 0 ? ok : ov;
#pragma unroll
        EPI_LOOP_ROWS {
            const int row = u.pm * 256 + ai * 128 + wr * 64 + m * 16 + fr;
#pragma unroll
            for (int bj = 0; bj < 2; ++bj) {
                const f32x4 v0 = acc[ai][bj][m][0], v1 = acc[ai][bj][m][1];
                const int cl = colw + bj * 128;
                *(u32x4*)(mkv + (size_t)row * 512 + u.pn * 256 + cl) = pack8(v0, v1);
                float* p = fo + (size_t)row * 256 + cl; *(f32x4*)p = v0; *(f32x4*)(p + 4) = v1;
            }
        }
    }
};

#define MFMA32(a, b, c) __builtin_amdgcn_mfma_f32_32x32x16_bf16((a), (b), (c), 0, 0, 0)
typedef short v4i16_t __attribute__((ext_vector_type(4)));
constexpr int AT_KP = 144, AT_VP = 192;
__device__ __forceinline__ int crow(int r, int h) { return (r & 3) + 8 * (r >> 2) + 4 * h; }
__device__ __forceinline__ s16x4 vtr(const LAS unsigned char* p) { return __builtin_bit_cast(s16x4, __builtin_amdgcn_ds_read_tr16_b64_v4i16((LAS v4i16_t*)p)); }
template <int MAXKB, int NPASS, bool ALIBI, bool FULL = false>
__device__ __forceinline__ void attn_core(const LAS unsigned char* Ks, const LAS unsigned char* Vs, int nkb, const bf16x8 (&qf)[4], bf16_t* optr,
                                          float scale2, float slope2, float sink2, int qrel, int lane) {
    const int r32 = lane & 31, h = lane >> 5;
    const LAS unsigned char* kbase = Ks + r32 * AT_KP + 16 * h;
    const LAS unsigned char* vbase = Vs + (4 * h + ((lane & 15) >> 2)) * AT_VP + 32 * ((lane >> 4) & 1) + 8 * (lane & 3);
    float m_run = ALIBI ? sink2 : -3.0e38f, l = 0.f;
    const float qd = (float)(qrel - 4 * h);
    f32x16 o0, o1;
#pragma unroll
    for (int i = 0; i < 16; ++i) { o0[i] = 0.f; o1[i] = 0.f; }
#pragma unroll
    for (int pass = 0; pass < NPASS; ++pass) {
        f32x16 st[MAXKB];
#pragma unroll
        for (int kk = 0; kk < MAXKB; ++kk) {
            const int kb = pass * MAXKB + kk;
#pragma unroll
            for (int i = 0; i < 16; ++i) st[kk][i] = 0.f;
            if (FULL || kb < nkb) {
#pragma unroll
                for (int ds = 0; ds < 4; ++ds) {
                    const bf16x8 kf = *(const LAS bf16x8*)(kbase + kb * 32 * AT_KP + 32 * ds);
                    st[kk] = MFMA32(kf, qf[ds], st[kk]);
                }
            }
        }
        float mx = m_run;
#pragma unroll
        for (int kk = 0; kk < MAXKB; ++kk) { const int kb = pass * MAXKB + kk; if (FULL || kb < nkb) {
#pragma unroll
            for (int i = 0; i < 16; ++i) {
                float s = st[kk][i] * scale2;
                if (ALIBI) s -= slope2 * fabsf(qd - (float)(kb * 32 + (i & 3) + 8 * (i >> 2)));
                st[kk][i] = s; mx = fmaxf(mx, s);
            } } }
        mx = fmaxf(mx, __shfl_xor(mx, 32));
        if (pass > 0) { const float corr = __builtin_amdgcn_exp2f(m_run - mx); l *= corr;
#pragma unroll
            for (int i = 0; i < 16; ++i) { o0[i] *= corr; o1[i] *= corr; } }
        m_run = mx;
#pragma unroll
        for (int kk = 0; kk < MAXKB; ++kk) { const int kb = pass * MAXKB + kk; if (FULL || kb < nkb) {
#pragma unroll
            for (int i = 0; i < 16; ++i) { const float p = __builtin_amdgcn_exp2f(st[kk][i] - mx); st[kk][i] = p; l += p; } } }
#pragma unroll
        for (int kk = 0; kk < MAXKB; ++kk) { const int kb = pass * MAXKB + kk; if (FULL || kb < nkb) {
#pragma unroll
            for (int s = 0; s < 2; ++s) {
                u32x4 pw; pw.x = cvtpk(st[kk][8 * s + 0], st[kk][8 * s + 1]); pw.y = cvtpk(st[kk][8 * s + 2], st[kk][8 * s + 3]);
                pw.z = cvtpk(st[kk][8 * s + 4], st[kk][8 * s + 5]); pw.w = cvtpk(st[kk][8 * s + 6], st[kk][8 * s + 7]);
                const bf16x8 xs = __builtin_bit_cast(bf16x8, pw);
                const LAS unsigned char* vp = vbase + (kb * 32 + 16 * s) * AT_VP;
                {
                    const s16x4 lo = vtr(vp), hi = vtr(vp + 8 * AT_VP);
                    o0 = MFMA32(__builtin_shufflevector(lo, hi, 0, 1, 2, 3, 4, 5, 6, 7), xs, o0);
                }
                {
                    const s16x4 lo = vtr(vp + 64), hi = vtr(vp + 8 * AT_VP + 64);
                    o1 = MFMA32(__builtin_shufflevector(lo, hi, 0, 1, 2, 3, 4, 5, 6, 7), xs, o1);
                }
            } } }
    }
    l += __shfl_xor(l, 32);
    if (ALIBI) l += __builtin_amdgcn_exp2f(sink2 - m_run);
    const float rl = 1.0f / l;
#pragma unroll
    for (int g = 0; g < 4; ++g) {
        u32x2 w0, w1;
        w0.x = cvtpk(o0[4 * g] * rl, o0[4 * g + 1] * rl); w0.y = cvtpk(o0[4 * g + 2] * rl, o0[4 * g + 3] * rl);
        w1.x = cvtpk(o1[4 * g] * rl, o1[4 * g + 1] * rl); w1.y = cvtpk(o1[4 * g + 2] * rl, o1[4 * g + 3] * rl);
        *(u32x2*)(optr + 8 * g + 4 * h) = w0;
        *(u32x2*)(optr + 32 + 8 * g + 4 * h) = w1;
    }
}

__device__ __forceinline__ bf16x8 cvt8(const float* p) { const f32x4 a = *(const f32x4*)p, b = *(const f32x4*)(p + 4); return __builtin_bit_cast(bf16x8, pack8(a, b)); }
template <int NIT> __device__ __forceinline__ void kv_store(LAS unsigned char* Ks, LAS unsigned char* Vs, int nk8, int tid, const bf16x8 (&kr)[NIT], const bf16x8 (&vr)[NIT]) {
#pragma unroll
    for (int it = 0; it < NIT; ++it) { const int idx = tid + it * 512; if (idx < nk8) { const int key = idx >> 3, ch = idx & 7;
        *(LAS bf16x8*)(Ks + key * AT_KP + ch * 16) = kr[it]; *(LAS bf16x8*)(Vs + key * AT_VP + ch * 16) = vr[it]; } }
}
constexpr int SW_VS_OFF = 192 * AT_KP, XA_VS_OFF = 256 * AT_KP;
constexpr int N_SWA_UNITS = NB * 32 * 4 + DB * 4;
constexpr int N_XA_UNITS = NB * 4 * 8 + DB * 4;

struct SwaUnit { int nk, nq, qrow0, krow0, kvh, b; };
__device__ __forceinline__ void swa_decode(int unit, SwaUnit& U) {
    if (unit < 1024) { const int b = unit >> 7, c = (unit >> 2) & 31, back = c < 2 ? c : 2; U.kvh = unit & 3; U.b = b; U.nk = (back + 1) * 64; U.nq = 64; U.qrow0 = b * SEQ + c * 64; U.krow0 = U.qrow0 - back * 64; }
    else { const int su = unit - 1024; U.b = su >> 2; U.kvh = su & 3; U.nk = 160; U.nq = 32; U.qrow0 = MP + U.b * 32; U.krow0 = U.qrow0 - 128; }
}
__device__ __forceinline__ void swa_load(const SwaUnit& U, int l, const bf16_t* zkv, const float* cak, const float* cav, int tid, bf16x8 (&kr)[3], bf16x8 (&vr)[3]) {
#pragma unroll
    for (int it = 0; it < 3; ++it) { const int idx = tid + it * 512; if (idx < U.nk * 8) { const int key = idx >> 3, ch = idx & 7;
        if (U.nq == 32 && key < 128) { const size_t off = ((((size_t)l * DB + U.b) * 128 + key) * 4 + U.kvh) * 64 + ch * 8; kr[it] = cvt8(cak + off); vr[it] = cvt8(cav + off); }
        else { const bf16_t* p = zkv + (size_t)(U.krow0 + key) * 512 + U.kvh * 64 + ch * 8; kr[it] = *(const bf16x8*)p; vr[it] = *(const bf16x8*)(p + 256); } } }
}
__device__ __forceinline__ void swa_phase(int l, LAS unsigned char* lds, bf16_t* zq, const bf16_t* zkv, const float* cak, const float* cav, const float* sinks, int tid, int bid, int G) {
    LAS unsigned char* Ks = lds; LAS unsigned char* Vs = lds + SW_VS_OFF;
    bf16x8 kr[3], vr[3]; SwaUnit U, Un; int u = bid;
    float sk[4];
#pragma unroll
    for (int k4 = 0; k4 < 4; ++k4) sk[k4] = sinks[l * 16 + k4 * 4 + (tid >> 7)] * LOG2E;
    if (u < N_SWA_UNITS) { swa_decode(u, U); swa_load(U, l, zkv, cak, cav, tid, kr, vr); }
    while (u < N_SWA_UNITS) {
        int tq = tid; asm volatile("" : "+v"(tq));
        const int lane = tq & 63, wave = tq >> 6, g = wave >> 1, qh = wave & 1, h = lane >> 5;
        kv_store<3>(Ks, Vs, U.nk * 8, tq, kr, vr);
        const bool active = qh * 32 < U.nq; const int head = U.kvh * 4 + g, qi = qh * 32 + (lane & 31);
        bf16_t* qp = zq + (size_t)(U.qrow0 + qi) * 1024 + head * 64;
        bf16x8 qf[4];
        if (active) {
#pragma unroll
            for (int ds = 0; ds < 4; ++ds) qf[ds] = *(const bf16x8*)(qp + 16 * ds + 8 * h);
        }
        __syncthreads();
        const int un = u + G;
        if (un < N_SWA_UNITS) { int tl = tid; asm volatile("" : "+v"(tl)); swa_decode(un, Un); swa_load(Un, l, zkv, cak, cav, tl, kr, vr); }
        if (active) {
            const float slope = exp2f(-0.5f * (float)(head + 1));
            const float sink2 = U.kvh == 0 ? sk[0] : U.kvh == 1 ? sk[1] : U.kvh == 2 ? sk[2] : sk[3];
            if (U.nk == 192) attn_core<3, 2, true, true>(Ks, Vs, 6, qf, qp, 0.125f * LOG2E, slope * LOG2E, sink2, (192 - 64) + qi, lane);
            else attn_core<3, 2, true>(Ks, Vs, U.nk >> 5, qf, qp, 0.125f * LOG2E, slope * LOG2E, sink2, (U.nk - U.nq) + qi, lane);
        }
        __syncthreads();
        u = un; U = Un;
    }
}
struct XaUnit { int qrow0, h, b, nwaves; };
__device__ __forceinline__ void xa_decode(int unit, XaUnit& U) {
    if (unit < 256) { U.b = unit >> 5; U.h = (unit >> 3) & 3; U.qrow0 = U.b * SEQ + (unit & 7) * 256; U.nwaves = 8; }
    else { const int su = unit - 256; U.b = su >> 2; U.h = su & 3; U.qrow0 = MP + U.b * 32; U.nwaves = 1; }
}
__device__ __forceinline__ void xa_load(const XaUnit& U, int l, const bf16_t* mkv, const float* cmk, const float* cmv, int tid, bf16x8 (&kr)[4], bf16x8 (&vr)[4]) {
#pragma unroll
    for (int it = 0; it < 4; ++it) { const int idx = tid + it * 512, key = idx >> 3, ch = idx & 7;
        if (U.nwaves == 8) { const bf16_t* p = mkv + (size_t)(U.b * 256 + key) * 512 + U.h * 64 + ch * 8; kr[it] = *(const bf16x8*)p; vr[it] = *(const bf16x8*)(p + 256); }
        else { const size_t off = ((((size_t)l * DB + U.b) * 256 + key) * 4 + U.h) * 64 + ch * 8; kr[it] = cvt8(cmk + off); vr[it] = cvt8(cmv + off); } }
}
__device__ __forceinline__ void xa_phase(int l, LAS unsigned char* lds, const bf16_t* cq, bf16_t* co, const bf16_t* mkv, const float* cmk, const float* cmv, int tid, int bid, int G) {
    LAS unsigned char* Ks = lds; LAS unsigned char* Vs = lds + XA_VS_OFF;
    bf16x8 kr[4], vr[4]; XaUnit U, Un; int u = bid;
    if (u < N_XA_UNITS) { xa_decode(u, U); xa_load(U, l, mkv, cmk, cmv, tid, kr, vr); }
    while (u < N_XA_UNITS) {
        int tq = tid; asm volatile("" : "+v"(tq));
        const int lane = tq & 63, wave = tq >> 6, h = lane >> 5;
        kv_store<4>(Ks, Vs, 2048, tq, kr, vr);
        const bool active = wave < U.nwaves;
        const size_t off = (size_t)(U.qrow0 + wave * 32 + (lane & 31)) * 256 + U.h * 64;
        bf16x8 qf[4];
        if (active) {
#pragma unroll
            for (int ds = 0; ds < 4; ++ds) qf[ds] = *(const bf16x8*)(cq + off + 16 * ds + 8 * h);
        }
        __syncthreads();
        const int un = u + G;
        if (un < N_XA_UNITS) { int tl = tid; asm volatile("" : "+v"(tl)); xa_decode(un, Un); xa_load(Un, l, mkv, cmk, cmv, tl, kr, vr); }
        if (active) attn_core<4, 2, false>(Ks, Vs, 8, qf, co + off, 0.125f * LOG2E, 0.f, 0.f, 0, lane);
        __syncthreads();
        u = un; U = Un;
    }
}

__device__ __forceinline__ void conv_item(int wi, const bf16_t* zch, bf16_t* zcb, const bf16_t* zcc, const float* cw, const float* state, float* ocp, float* ocs, int tid) {
    const int r0 = wi * 64 + (tid >> 7) * 16, c = (tid & 127) * 8;
    float w0[8], w1[8], w2[8], um2[8], um1[8];
    { const f32x4 a = *(const f32x4*)(cw + c), b = *(const f32x4*)(cw + c + 4), d = *(const f32x4*)(cw + 1024 + c), e = *(const f32x4*)(cw + 1024 + c + 4), f = *(const f32x4*)(cw + 2048 + c), g = *(const f32x4*)(cw + 2048 + c + 4);
#pragma unroll
      for (int i = 0; i < 4; ++i) { w0[i] = a[i]; w0[4 + i] = b[i]; w1[i] = d[i]; w1[4 + i] = e[i]; w2[i] = f[i]; w2[4 + i] = g[i]; } }
    const bool is_p = r0 < MP; const int t0 = is_p ? (r0 & (SEQ - 1)) : ((r0 - MP) & 31); const int b = is_p ? (r0 >> 11) : ((r0 - MP) >> 5);
    {
        const int rh = r0 >= 2 ? r0 - 2 : 0;
        const u32x4 hm2 = *(const u32x4*)(zch + (size_t)rh * 1024 + c), hm1 = *(const u32x4*)(zch + (size_t)(rh + 1) * 1024 + c);
        const float* s = state + (size_t)(is_p ? 0 : b) * 2048 + c;
        const f32x4 sa = *(const f32x4*)s, sb = *(const f32x4*)(s + 4), sd = *(const f32x4*)(s + 1024), se = *(const f32x4*)(s + 1028);
        f32x4 h0, h1, g0, g1; unpack8(hm2, h0, h1); unpack8(hm1, g0, g1);
        const bool st = t0 == 0;
#pragma unroll
        for (int i = 0; i < 4; ++i) {
            um2[i] = st ? (is_p ? 0.f : sa[i]) : h0[i]; um2[4 + i] = st ? (is_p ? 0.f : sb[i]) : h1[i];
            um1[i] = st ? (is_p ? 0.f : sd[i]) : g0[i]; um1[4 + i] = st ? (is_p ? 0.f : se[i]) : g1[i];
        }
    }
#pragma unroll
    for (int tb = 0; tb < 16; tb += 8) {
        u32x4 uw[8], bw[8];
#pragma unroll
        for (int t = 0; t < 8; ++t) { const size_t off = (size_t)(r0 + tb + t) * 1024 + c; uw[t] = *(const u32x4*)(zch + off); bw[t] = *(const u32x4*)(zcb + off); }
#pragma unroll
        for (int t = 0; t < 8; ++t) {
            const size_t off = (size_t)(r0 + tb + t) * 1024 + c;
            f32x4 h0, h1, b0, b1;
            unpack8(uw[t], h0, h1); unpack8(bw[t], b0, b1);
            float u[8]; f32x4 r0v, r1v;
#pragma unroll
            for (int i = 0; i < 4; ++i) { u[i] = h0[i]; u[4 + i] = h1[i]; }
#pragma unroll
            for (int i = 0; i < 4; ++i) {
                r0v[i] = b0[i] * (um2[i] * w0[i] + um1[i] * w1[i] + u[i] * w2[i]);
                r1v[i] = b1[i] * (um2[4 + i] * w0[4 + i] + um1[4 + i] * w1[4 + i] + u[4 + i] * w2[4 + i]);
            }
            *(u32x4*)(zcb + off) = pack8(r0v, r1v);
#pragma unroll
            for (int i = 0; i < 8; ++i) { um2[i] = um1[i]; um1[i] = u[i]; }
        }
    }
    if (t0 + 15 == (is_p ? SEQ - 1 : DSQ - 1)) {
        float* o = (is_p ? ocp : ocs) + (size_t)b * 2048 + c;
        *(f32x4*)o = (f32x4){um2[0], um2[1], um2[2], um2[3]}; *(f32x4*)(o + 4) = (f32x4){um2[4], um2[5], um2[6], um2[7]};
        *(f32x4*)(o + 1024) = (f32x4){um1[0], um1[1], um1[2], um1[3]}; *(f32x4*)(o + 1028) = (f32x4){um1[4], um1[5], um1[6], um1[7]};
    }
}

__device__ __forceinline__ int win_perm(int n) {
    if (n < 1536 || n >= 4608) return n;
    if (n < 2560) { const int c = n - 1536; return 1536 + 256 * (c >> 7) + (c & 127); }
    if (n < 3584) return n + 1024;
    const int c = n - 3584; return 1536 + 256 * (c >> 7) + 128 + (c & 127);
}
template <bool WINPERM = false>
__device__ __forceinline__ void transpose_item(const float* W, int K, int N, const float* g, bf16_t* WT, LAS float* scr, int item, int lane) {
    const int nblk = N / 32, kb = item / nblk, nb = item % nblk, k0 = 64 * kb, n0 = 32 * nb; const int n0d = WINPERM ? win_perm(n0) : n0;
#pragma unroll
    for (int i = 0; i < 8; ++i) { const int kk = 8 * i + (lane >> 3), n4 = (lane & 7) * 4; f32x4 v = *(const f32x4*)(W + (size_t)(k0 + kk) * N + n0 + n4); if (g) v = v * g[k0 + kk];
        LAS float* d = scr + kk * 33 + n4; d[0] = v[0]; d[1] = v[1]; d[2] = v[2]; d[3] = v[3]; }
    asm volatile("s_waitcnt lgkmcnt(0)" ::: "memory");
    const int c = lane & 7;
#pragma unroll
    for (int j = 0; j < 4; ++j) { const int n = (lane >> 3) + 8 * j; const LAS float* s = scr + (8 * c) * 33 + n;
        u32x4 o; o.x = cvtpk(s[0 * 33], s[1 * 33]); o.y = cvtpk(s[2 * 33], s[3 * 33]); o.z = cvtpk(s[4 * 33], s[5 * 33]); o.w = cvtpk(s[6 * 33], s[7 * 33]);
        *(u32x4*)(WT + (size_t)(n0d + n) * K + k0 + 8 * c) = o; }
    asm volatile("s_waitcnt lgkmcnt(0)" ::: "memory");
}
__device__ __forceinline__ void row_prep(const float* src, float* xcopy, bf16_t* xb, float* ssq, bool norm, int lane) {
    const f32x4* xr = (const f32x4*)src + lane;
    f32x4 v[4]; float s = 0.f;
#pragma unroll
    for (int j = 0; j < 4; ++j) { v[j] = xr[64 * j]; s += (v[j][0] * v[j][0] + v[j][1] * v[j][1]) + (v[j][2] * v[j][2] + v[j][3] * v[j][3]); }
    s = wave_sum(s);
    const float sc = norm ? rsqrtf(s * (1.0f / DM) + EPS) : 1.0f;
    if (xcopy) {
#pragma unroll
        for (int j = 0; j < 4; ++j) ((f32x4*)xcopy + lane)[64 * j] = v[j];
    }
    u32x2* o8 = (u32x2*)xb + lane;
#pragma unroll
    for (int j = 0; j < 4; ++j) { u32x2 w; w.x = cvtpk(v[j][0] * sc, v[j][1] * sc); w.y = cvtpk(v[j][2] * sc, v[j][3] * sc); o8[64 * j] = w; }
    if (ssq && lane < 16) ssq[lane] = lane == 0 ? s : 0.f;
}

#define MFMA16(a, b, c) __builtin_amdgcn_mfma_f32_16x16x32_bf16((a), (b), (c), 0, 0, 0)
template <int KCH, class F>
__device__ __forceinline__ void sgemm_tile(LAS unsigned char* lds, const bf16_t* A, const bf16_t* Bt, int K, int row0, int col0, int tid, const F& f) {
    const int wave = tid >> 6, lane = tid & 63, fr = lane & 15, fq = lane >> 4;
    const int ks = K >> 3;
    const bf16_t* ap = A + (size_t)(row0 + fr) * K + wave * ks + fq * 16;
    const bf16_t* bp = Bt + (size_t)(col0 + fr) * K + wave * ks + fq * 16;
    const int r = tid >> 3, ch = (tid & 7) * 2;
    typename F::Pre pre = f.load(row0 + r, col0 + ch * 4);
    f32x4 acc[4][4];
#pragma unroll
    for (int m = 0; m < 4; ++m)
#pragma unroll
        for (int n = 0; n < 4; ++n) acc[m][n] = (f32x4){0.f, 0.f, 0.f, 0.f};
    if (KCH == 1) {
        bf16x8 af[4], bf[4];
#pragma unroll
        for (int m = 0; m < 4; ++m) af[m] = *(const bf16x8*)(ap + (size_t)m * 16 * K - fq * 8);
#pragma unroll
        for (int n = 0; n < 4; ++n) bf[n] = *(const bf16x8*)(bp + (size_t)n * 16 * K - fq * 8);
#pragma unroll
        for (int m = 0; m < 4; ++m)
#pragma unroll
            for (int n = 0; n < 4; ++n) acc[m][n] = MFMA16(bf[n], af[m], acc[m][n]);
    } else {
        for (int k = 0; k < ks; k += 128) {
            bf16x8 af[4][4], bf[4][4];
#pragma unroll
            for (int c = 0; c < 4; ++c) {
#pragma unroll
                for (int m = 0; m < 4; ++m) af[c][m] = *(const bf16x8*)(ap + (size_t)m * 16 * K + k + 64 * (c >> 1) + 8 * (c & 1));
#pragma unroll
                for (int n = 0; n < 4; ++n) bf[c][n] = *(const bf16x8*)(bp + (size_t)n * 16 * K + k + 64 * (c >> 1) + 8 * (c & 1));
            }
#pragma unroll
            for (int c = 0; c < 4; ++c)
#pragma unroll
                for (int m = 0; m < 4; ++m)
#pragma unroll
                    for (int n = 0; n < 4; ++n) acc[m][n] = MFMA16(bf[c][n], af[c][m], acc[m][n]);
        }
    }
    LAS float* part = (LAS float*)lds + wave * 4096;
#pragma unroll
    for (int m = 0; m < 4; ++m)
#pragma unroll
        for (int n = 0; n < 4; ++n) *(LAS f32x4*)(part + (m * 16 + fr) * 64 + (((n * 4 + fq) ^ fr) << 2)) = acc[m][n];
    __syncthreads();
    f32x4 v0 = (f32x4){0.f, 0.f, 0.f, 0.f}, v1 = v0;
#pragma unroll
    for (int w = 0; w < 8; ++w) { const LAS float* p = (const LAS float*)lds + w * 4096 + r * 64;
        v0 += *(const LAS f32x4*)(p + ((ch ^ (r & 15)) << 2)); v1 += *(const LAS f32x4*)(p + (((ch + 1) ^ (r & 15)) << 2)); }
    f.apply(row0 + r, col0 + ch * 4, v0, v1, pre);
    __syncthreads();
}
struct SGate1 { bf16_t* zga; struct Pre { u32x4 g; };
    __device__ __forceinline__ Pre load(int row, int col) const { Pre p; p.g = *(const u32x4*)(zga + (size_t)row * 1024 + col); return p; }
    __device__ __forceinline__ void apply(int row, int col, f32x4 v0, f32x4 v1, const Pre& pr) const {
        f32x4 g0, g1; unpack8(pr.g, g0, g1);
#pragma unroll
        for (int e = 0; e < 4; ++e) { v0[e] *= sigmoidf_(g0[e]); v1[e] *= sigmoidf_(g1[e]); }
        *(u32x4*)(zga + (size_t)row * 1024 + col) = pack8(v0, v1); } };
struct SGate2 { bf16_t* zga; const bf16_t* zgb; struct Pre { u32x4 t, g; };
    __device__ __forceinline__ Pre load(int row, int col) const { const size_t off = (size_t)row * 1024 + col; Pre p; p.t = *(const u32x4*)(zga + off); p.g = *(const u32x4*)(zgb + off); return p; }
    __device__ __forceinline__ void apply(int row, int col, f32x4 v0, f32x4 v1, const Pre& pr) const {
        f32x4 t0, t1, g0, g1; unpack8(pr.t, t0, t1); unpack8(pr.g, g0, g1);
#pragma unroll
        for (int e = 0; e < 4; ++e) { v0[e] = t0[e] + v0[e] * sigmoidf_(g0[e]); v1[e] = t1[e] + v1[e] * sigmoidf_(g1[e]); }
        *(u32x4*)(zga + (size_t)row * 1024 + col) = pack8(v0, v1); } };
struct SResid { float* x; bf16_t* xb; float* ssq; const float* ssq_in; struct Pre { u32x4 w; float rs2; };
    __device__ __forceinline__ Pre load(int row, int col) const { Pre p; p.w = *(const u32x4*)(xb + (size_t)row * 1024 + col);
        p.rs2 = 1.f; if (ssq_in) { const float r_ = row_rstd(ssq_in, row); p.rs2 = r_ * r_; } return p; }
    __device__ __forceinline__ void apply(int row, int col, f32x4 v0, f32x4 v1, const Pre& pr) const {
        const size_t off = (size_t)row * 1024 + col;
        f32x4 x0, x1; unpack8(pr.w, x0, x1);
        v0 = v0 * pr.rs2 + x0; v1 = v1 * pr.rs2 + x1;
        *(u32x4*)(xb + off) = pack8(v0, v1);
        float sq = (v0[0] * v0[0] + v0[1] * v0[1]) + (v0[2] * v0[2] + v0[3] * v0[3]) + (v1[0] * v1[0] + v1[1] * v1[1]) + (v1[2] * v1[2] + v1[3] * v1[3]);
        sq += __shfl_xor(sq, 1); sq += __shfl_xor(sq, 2); sq += __shfl_xor(sq, 4);
        if ((col & 63) == 0) ssq[(size_t)row * 16 + (col >> 6)] = sq; } };
struct SUp { bf16_t* o; const float* ssq; struct Pre { float rs; };
    __device__ __forceinline__ Pre load(int row, int col) const { Pre p; p.rs = row_rstd(ssq, row); return p; }
    __device__ __forceinline__ void apply(int row, int col, f32x4 v0, f32x4 v1, const Pre& pr) const {
        const float rs = pr.rs;
#pragma unroll
        for (int e = 0; e < 4; ++e) { const float a = fmaxf(v0[e] * rs, 0.f), b = fmaxf(v1[e] * rs, 0.f); v0[e] = a * a; v1[e] = b * b; }
        *(u32x4*)(o + (size_t)row * FF + col) = pack8(v0, v1); } };

__device__ __forceinline__ void sgemm_tile_gate2(LAS unsigned char* lds, const bf16_t* A0, const bf16_t* B0, const bf16_t* A1, const bf16_t* B1, int K, int row0, int col0, int tid,
                                                 bf16_t* zga, const bf16_t* zgb) {
    const int wave = tid >> 6, lane = tid & 63, fr = lane & 15, fq = lane >> 4;
    const int ks = K >> 2, wq = wave & 3;
    const bf16_t* A = wave < 4 ? A0 : A1; const bf16_t* Bt = wave < 4 ? B0 : B1;
    const bf16_t* ap = A + (size_t)(row0 + fr) * K + wq * ks + fq * 16;
    const bf16_t* bp = Bt + (size_t)(col0 + fr) * K + wq * ks + fq * 16;
    const int r = tid >> 3, ch = (tid & 7) * 2;
    const size_t goff = (size_t)(row0 + r) * 1024 + col0 + ch * 4;
    const u32x4 gaw = *(const u32x4*)(zga + goff), gbw = *(const u32x4*)(zgb + goff);
    f32x4 acc[4][4];
#pragma unroll
    for (int m = 0; m < 4; ++m)
#pragma unroll
        for (int n = 0; n < 4; ++n) acc[m][n] = (f32x4){0.f, 0.f, 0.f, 0.f};
    for (int k = 0; k < ks; k += 128) {
        bf16x8 af[4][4], bf[4][4];
#pragma unroll
        for (int c = 0; c < 4; ++c) {
#pragma unroll
            for (int m = 0; m < 4; ++m) af[c][m] = *(const bf16x8*)(ap + (size_t)m * 16 * K + k + 64 * (c >> 1) + 8 * (c & 1));
#pragma unroll
            for (int n = 0; n < 4; ++n) bf[c][n] = *(const bf16x8*)(bp + (size_t)n * 16 * K + k + 64 * (c >> 1) + 8 * (c & 1));
        }
#pragma unroll
        for (int c = 0; c < 4; ++c)
#pragma unroll
            for (int m = 0; m < 4; ++m)
#pragma unroll
                for (int n = 0; n < 4; ++n) acc[m][n] = MFMA16(bf[c][n], af[c][m], acc[m][n]);
    }
    LAS float* part = (LAS float*)lds + wave * 4096;
#pragma unroll
    for (int m = 0; m < 4; ++m)
#pragma unroll
        for (int n = 0; n < 4; ++n) *(LAS f32x4*)(part + (m * 16 + fr) * 64 + (((n * 4 + fq) ^ fr) << 2)) = acc[m][n];
    __syncthreads();
    f32x4 a0 = (f32x4){0.f, 0.f, 0.f, 0.f}, a1 = a0, b0 = a0, b1 = a0;
#pragma unroll
    for (int w = 0; w < 4; ++w) { const LAS float* p = (const LAS float*)lds + w * 4096 + r * 64;
        a0 += *(const LAS f32x4*)(p + ((ch ^ (r & 15)) << 2)); a1 += *(const LAS f32x4*)(p + (((ch + 1) ^ (r & 15)) << 2));
        b0 += *(const LAS f32x4*)(p + 4 * 4096 + ((ch ^ (r & 15)) << 2)); b1 += *(const LAS f32x4*)(p + 4 * 4096 + (((ch + 1) ^ (r & 15)) << 2)); }
    f32x4 ga0, ga1, gb0, gb1; unpack8(gaw, ga0, ga1); unpack8(gbw, gb0, gb1);
#pragma unroll
    for (int e = 0; e < 4; ++e) { a0[e] = a0[e] * sigmoidf_(ga0[e]) + b0[e] * sigmoidf_(gb0[e]); a1[e] = a1[e] * sigmoidf_(ga1[e]) + b1[e] * sigmoidf_(gb1[e]); }
    *(u32x4*)(zga + goff) = pack8(a0, a1);
    __syncthreads();
}

__device__ __forceinline__ void row_prep2(const float* srcA, float* xcA, bf16_t* xbA, float* ssqA, bool normA, const float* srcB, float* xcB, bf16_t* xbB, float* ssqB, bool normB, bool hasB, int lane) {
    const f32x4* pa = (const f32x4*)srcA + lane; const f32x4* pb = (const f32x4*)srcB + lane;
    f32x4 va[4], vb[4]; float sa = 0.f, sb = 0.f;
#pragma unroll
    for (int j = 0; j < 4; ++j) { va[j] = pa[64 * j]; vb[j] = pb[64 * j]; }
#pragma unroll
    for (int j = 0; j < 4; ++j) { sa += (va[j][0] * va[j][0] + va[j][1] * va[j][1]) + (va[j][2] * va[j][2] + va[j][3] * va[j][3]);
                                  sb += (vb[j][0] * vb[j][0] + vb[j][1] * vb[j][1]) + (vb[j][2] * vb[j][2] + vb[j][3] * vb[j][3]); }
#pragma unroll
    for (int o = 1; o < 64; o <<= 1) { sa += __shfl_xor(sa, o); sb += __shfl_xor(sb, o); }
    const float ca = normA ? rsqrtf(sa * (1.0f / DM) + EPS) : 1.0f, cb = normB ? rsqrtf(sb * (1.0f / DM) + EPS) : 1.0f;
    u32x2* oa = (u32x2*)xbA + lane; u32x2* ob = (u32x2*)xbB + lane;
#pragma unroll
    for (int j = 0; j < 4; ++j) { u32x2 w; w.x = cvtpk(va[j][0] * ca, va[j][1] * ca); w.y = cvtpk(va[j][2] * ca, va[j][3] * ca); oa[64 * j] = w; }
    if (xcA) {
#pragma unroll
        for (int j = 0; j < 4; ++j) ((f32x4*)xcA + lane)[64 * j] = va[j];
    }
    if (ssqA && lane < 16) ssqA[lane] = lane == 0 ? sa : 0.f;
    if (hasB) {
        if (xcB) {
#pragma unroll
            for (int j = 0; j < 4; ++j) ((f32x4*)xcB + lane)[64 * j] = vb[j];
        }
#pragma unroll
        for (int j = 0; j < 4; ++j) { u32x2 w; w.x = cvtpk(vb[j][0] * cb, vb[j][1] * cb); w.y = cvtpk(vb[j][2] * cb, vb[j][3] * cb); ob[64 * j] = w; }
        if (ssqB && lane < 16) ssqB[lane] = lane == 0 ? sb : 0.f;
    }
}
#define XB_TMO      128
#define XB_XCNT(j)  (256  + 64 * (j))
#define XB_XSUB(j)  (1280 + 64 * (j))
#define XB_XGEN(j)  (2304 + 64 * (j))
#define XB_TOP      3328
#define XB_TOPGEN   3392
#define XCD_BAR_WORDS 3456
#define XB_SPIN_CAP (1u << 18)

__device__ __forceinline__ unsigned xb_ld(unsigned* p)              { return __hip_atomic_load(p, __ATOMIC_RELAXED, __HIP_MEMORY_SCOPE_AGENT); }
__device__ __forceinline__ unsigned xb_add(unsigned* p, unsigned v) { return __hip_atomic_fetch_add(p, v, __ATOMIC_RELAXED, __HIP_MEMORY_SCOPE_AGENT); }
__device__ __forceinline__ unsigned xb_xcc_id() { return (unsigned)__builtin_amdgcn_s_getreg((3 << 11) | 20) & 0xFu; }
#define XB_SPIN(cond, bar) do { unsigned _sp = 0; while (cond) { __builtin_amdgcn_s_sleep(1); \
    if ((++_sp & 255u) == 0u) { if (xb_ld(&(bar)[XB_TMO])) break; if (_sp > XB_SPIN_CAP) { atomicAdd(&(bar)[XB_TMO], 1u); break; } } } } while (0)

struct XcdBarrier {
    unsigned* bar; unsigned x;
    volatile LAS unsigned* st;
};

__device__ __forceinline__ XcdBarrier xcd_barrier_post(unsigned* bar, volatile LAS unsigned* st) {
    XcdBarrier b; b.bar = bar; b.x = xb_xcc_id(); b.st = st;
    if (threadIdx.x == 0) (void)xb_add(&bar[XB_XCNT(b.x)], 1u);
    return b;
}
__device__ __forceinline__ void xcd_barrier_complete(unsigned* bar, unsigned x, unsigned& nloc, unsigned& nx) {
    const unsigned G = gridDim.x * gridDim.y * gridDim.z;
    unsigned sum, cnt, mine, sp = 0u;
    for (;;) {
        sum = 0u; cnt = 0u; mine = 0u;
#pragma nounroll
        for (unsigned j = 0; j < 16; ++j) { const unsigned c = xb_ld(&bar[XB_XCNT(j)]); sum += c; cnt += (c > 0u) ? 1u : 0u; mine = (j == x) ? c : mine; }
        if (sum == G) break;
        __builtin_amdgcn_s_sleep(1);
        if ((++sp & 255u) == 0u) { if (xb_ld(&bar[XB_TMO])) break; if (sp > XB_SPIN_CAP) { atomicAdd(&bar[XB_TMO], 1u); break; } }
    }
    nloc = mine > 0u ? mine : 1u; nx = cnt > 0u ? cnt : 1u;
}

__device__ __forceinline__ void xcd_barrier(const XcdBarrier& b) {
    asm volatile("s_waitcnt vmcnt(0)" ::: "memory");
    __syncthreads();
    if (threadIdx.x == 0) {
        unsigned* bar = b.bar; const unsigned bx = xb_xcc_id();
        __builtin_amdgcn_s_waitcnt(0);
        unsigned nloc = b.st[0], nx = b.st[1];
        if (nloc == 0u) { xcd_barrier_complete(bar, bx, nloc, nx); b.st[0] = nloc; b.st[1] = nx; }
        const unsigned old = xb_add(&bar[XB_XSUB(bx)], 1u);
        const unsigned gen = old / nloc;
        if (old + 1u == (gen + 1u) * nloc) {
            __builtin_amdgcn_fence(__ATOMIC_RELEASE, "agent");
            asm volatile("s_waitcnt vmcnt(0)" ::: "memory");
            const unsigned og = xb_add(&bar[XB_TOP], 1u);
            const unsigned tg = og / nx;
            if (og + 1u == (tg + 1u) * nx) xb_add(&bar[XB_TOPGEN], 1u);
            else XB_SPIN(xb_ld(&bar[XB_TOPGEN]) == tg, bar);
            __builtin_amdgcn_fence(__ATOMIC_ACQUIRE, "agent");
            xb_add(&bar[XB_XGEN(bx)], 1u);
            asm volatile("s_waitcnt vmcnt(0)" ::: "memory");
        } else {
            XB_SPIN(xb_ld(&bar[XB_XGEN(bx)]) == gen, bar);
            __builtin_amdgcn_fence(__ATOMIC_ACQUIRE, "agent");
            asm volatile("s_waitcnt vmcnt(0)" ::: "memory");
        }
    }
    __syncthreads();
}

constexpr int RING_BYTES = 131072, LDS_BYTES = 132096;
struct Args { const float* in[24]; float* out; unsigned char* ws; };

#define GEMM_PHASE(EpiT, E, A_, Bt_, M_, N_, K_, CIDX) do { int k_ = (K_); asm volatile("" : "+s"(k_)); pg8::Gemm g_{(const pg8::bf16_t*)(A_), (const pg8::bf16_t*)(Bt_), (M_), (N_), k_}; pg8::StaticOrder S_; S_.init((M_), (N_), G, (CIDX)); \
    pg8::gemm_phase<EpiT, pg8::StaticOrder, true, true>(lds, g_, S_, (E)); } while (0)

#define STILES(NT, LGN, A_, Bt_, K_, F_) STILES_(4, NT, LGN, A_, Bt_, K_, F_)
#define STILES_(KCH, NT, LGN, A_, Bt_, K_, F_) do { int ts_ = threadIdx.x, kk_ = (K_); asm volatile("" : "+v"(ts_)); asm volatile("" : "+s"(kk_)); \
    for (int t_ = bid; t_ < (NT); t_ += G) sgemm_tile<KCH>(lds, (A_), (Bt_), kk_, MP + (t_ >> (LGN)) * 64, (t_ & ((1 << (LGN)) - 1)) * 64, ts_, (F_)); } while (0)

constexpr int I_IN = 16 * (NIN / 32), I_SQ = 16 * 32, I_CQ = 16 * 8, I_CKV = 16 * 16, I_CO = 4 * 32, I_UP = 16 * 128, I_DN = 64 * 32;
constexpr int I_LAYER = I_IN + 3 * I_SQ + I_CQ + I_CKV + I_CO + I_UP + I_DN;
__device__ __forceinline__ void convert_weights(const Args& a, bf16_t* WT, LAS unsigned char* lds, int l, int nitems, int gw, int NGW, int wave, int lane) {
    LAS float* scr = (LAS float*)(lds + wave * 16384);
    bf16_t* wl = WT + (size_t)l * W_LAYER;
    for (int it = gw; it < nitems; it += NGW) {
        int r = it; { int ln = lane; asm volatile("" : "+v"(ln)); lane = ln; }
        if (r < I_IN) { transpose_item<true>(a.in[9] + (size_t)l * DM * NIN, DM, NIN, a.in[8] + l * DM, wl + WO_IN, scr, r, lane); continue; } r -= I_IN;
        if (r < I_SQ) { transpose_item(a.in[12] + (size_t)l * DM * DM, DM, DM, nullptr, wl + WO_AO, scr, r, lane); continue; } r -= I_SQ;
        if (r < I_SQ) { transpose_item(a.in[13] + (size_t)l * DM * DM, DM, DM, nullptr, wl + WO_CV, scr, r, lane); continue; } r -= I_SQ;
        if (r < I_SQ) { transpose_item(a.in[14] + (size_t)l * DM * DM, DM, DM, nullptr, wl + WO_MIX, scr, r, lane); continue; } r -= I_SQ;
        if (r < I_CQ) { transpose_item(a.in[17] + (size_t)l * DM * 256, DM, 256, a.in[15] + l * DM, wl + WO_CQ, scr, r, lane); continue; } r -= I_CQ;
        if (r < I_CO) { transpose_item(a.in[19] + (size_t)l * 256 * DM, 256, DM, nullptr, wl + WO_CO, scr, r, lane); continue; } r -= I_CO;
        if (r < I_UP) { transpose_item(a.in[21] + (size_t)l * DM * FF, DM, FF, a.in[20] + l * DM, wl + WO_UP, scr, r, lane); continue; } r -= I_UP;
        if (r < I_DN) { transpose_item(a.in[22] + (size_t)l * FF * DM, FF, DM, nullptr, wl + WO_DN, scr, r, lane); continue; } r -= I_DN;
        transpose_item(a.in[18] + (size_t)l * DM * 512, DM, 512, a.in[16] + l * DM, wl + WO_CKV, scr, r, lane);
    }
}

__global__ void __launch_bounds__(512, 2) fwd_mega(Args a) {
    extern __shared__ __attribute__((aligned(16))) unsigned char lds_raw[];
    cg::grid_group grid = cg::this_grid();
    LAS unsigned char* lds = (LAS unsigned char*)lds_raw;
    const int tid = threadIdx.x, lane = tid & 63, wave = __builtin_amdgcn_readfirstlane(tid >> 6);
    const int G = gridDim.x, bid = blockIdx.x;
    unsigned char* ws = a.ws; float* out = a.out;
    bf16_t* XB = (bf16_t*)(ws + WS_XB); float* SSQ = (float*)(ws + WS_SSQ); bf16_t* MEMN = (bf16_t*)(ws + WS_MEMN); bf16_t* MKV = (bf16_t*)(ws + WS_MKV);
    bf16_t* CQ = (bf16_t*)(ws + WS_CQ); bf16_t* CO = (bf16_t*)(ws + WS_CO);
    bf16_t* ZQ = (bf16_t*)(ws + WS_ZQ); bf16_t* ZKV = (bf16_t*)(ws + WS_ZKV); bf16_t* ZCH = (bf16_t*)(ws + WS_ZCH); bf16_t* ZCB = (bf16_t*)(ws + WS_ZCB);
    bf16_t* ZCC = (bf16_t*)(ws + WS_ZCC); bf16_t* ZGA = (bf16_t*)(ws + WS_ZGA); bf16_t* ZGB = (bf16_t*)(ws + WS_ZGB); bf16_t* HID = (bf16_t*)(ws + WS_HID);
    bf16_t* WT = (bf16_t*)(ws + WS_W);
    float* X = out + O_Y;
    volatile LAS unsigned* MISC = (volatile LAS unsigned*)(lds + RING_BYTES);
    if (tid < 64) MISC[tid] = 0u;
    __syncthreads();
    XcdBarrier bar = xcd_barrier_post((unsigned*)ws + 1024, MISC + 8);
#define SEAM() xcd_barrier(bar)

    {
        const int gw = bid * 8 + wave, NGW = G * 8;
        convert_weights(a, WT, lds, 0, I_LAYER, gw, NGW, wave, lane);
        for (int m = gw; m < MT + 2048; m += 2 * NGW) {
            const int mB = m + NGW; const bool hasB = mB < MT + 2048; const int mb = hasB ? mB : m;
            const float* srcA = m < MP ? a.in[0] + (size_t)m * DM : m < MT ? a.in[1] + (size_t)(m - MP) * DM : a.in[2] + (size_t)(m - MT) * DM;
            const float* srcB = mb < MP ? a.in[0] + (size_t)mb * DM : mb < MT ? a.in[1] + (size_t)(mb - MP) * DM : a.in[2] + (size_t)(mb - MT) * DM;
            bf16_t* dA = m < MT ? XB + (size_t)m * DM : MEMN + (size_t)(m - MT) * DM; bf16_t* dB = mb < MT ? XB + (size_t)mb * DM : MEMN + (size_t)(mb - MT) * DM;
            row_prep2(srcA, nullptr, dA, m < MT ? SSQ + (size_t)m * 16 : nullptr, m >= MT,
                      srcB, nullptr, dB, mb < MT ? SSQ + (size_t)mb * 16 : nullptr, mb >= MT, hasB, lane);
        }
    }
    if (a.ws == nullptr) grid.sync();
    SEAM();

    float* SSQ1 = (float*)(ws + WS_ZGA - 2 * MiB);
    int si = 0;
#define SQ(i_) ((i_) ? SSQ1 : SSQ)
    for (int l = 0; l < DEPTH; ++l) {
        const bf16_t* wl = WT + (size_t)l * W_LAYER;
        {
            EpiZ E{ZQ, ZKV, ZCH, ZCB, ZCC, ZGA, ZGB, SQ(si), out + O_KP + (size_t)l * NB * 128 * 256, out + O_VP + (size_t)l * NB * 128 * 256,
                   out + O_KS + (size_t)l * DB * DSQ * 256, out + O_VS + (size_t)l * DB * DSQ * 256};
            { int c1 = bid; asm volatile("" : "+s"(c1)); GEMM_PHASE(EpiZ, E, XB, wl + WO_IN, MT, NIN, DM, c1); }
        }
        SEAM();
        {
            int t2 = threadIdx.x; asm volatile("" : "+v"(t2));
            for (int half = 0; half < 2; ++half) {
                if (((half ^ bid) & 1) == 0) swa_phase(l, lds, ZQ, ZKV, a.in[3], a.in[4], a.in[11], t2, bid, G);
                else {
                    for (int wi = G - 1 - bid; wi < MT / 64; wi += G)
                        conv_item(wi, ZCH, ZCB, ZCC, a.in[10] + (size_t)l * 3 * DM, a.in[5] + (size_t)l * DB * 2 * DM, out + O_CP + (size_t)l * NB * 2 * DM, out + O_CS + (size_t)l * DB * 2 * DM, t2);
                }
            }
        }
        SEAM();
        {
            EpiGate1 E1{ZGA}; GEMM_PHASE(EpiGate1, E1, ZQ, wl + WO_AO, MP, DM, DM, bid);
            EpiGate2 E2{ZGA, ZGB}; GEMM_PHASE(EpiGate2, E2, ZCB, wl + WO_CV, MP, DM, DM, bid);
            { int ts_ = threadIdx.x, kk_ = DM; asm volatile("" : "+v"(ts_)); asm volatile("" : "+s"(kk_));
              for (int t_ = bid; t_ < 256; t_ += G) sgemm_tile_gate2(lds, ZQ, wl + WO_AO, ZCB, wl + WO_CV, kk_, MP + (t_ >> 4) * 64, (t_ & 15) * 64, ts_, ZGA, ZGB); }
        }
        SEAM();
        {
            EpiResidT<false> E{X, XB, SQ(si ^ 1), nullptr}; GEMM_PHASE(EpiResidT<false>, E, ZGA, wl + WO_MIX, MP, DM, DM, bid); SResid F{X, XB, SQ(si ^ 1), nullptr}; STILES(256, 4, ZGA, wl + WO_MIX, DM, F); si ^= 1;
        }
        SEAM();
        {
            EpiScale<0> E{CQ, 256, SQ(si)}; GEMM_PHASE(EpiScale<0>, E, XB, wl + WO_CQ, MT, 256, DM, bid);
            {
                EpiMemKV EM{MKV + (size_t)l * 2048 * 512, out + O_MKP + (size_t)l * 2048 * 256, out + O_MVP + (size_t)l * 2048 * 256};
                GEMM_PHASE(EpiMemKV, EM, MEMN, wl + WO_CKV, 2048, 512, DM, (bid + G - 68) % G);
            }
            if (bid >= 84 && l + 1 < DEPTH) convert_weights(a, WT, lds, l + 1, I_LAYER, (bid - 84) * 8 + wave, (G - 84) * 8, wave, lane);
        }
        SEAM();
        {
            int t6 = threadIdx.x; asm volatile("" : "+v"(t6));
            xa_phase(l, lds, CQ, CO, MKV + (size_t)l * 2048 * 512, a.in[6], a.in[7], t6, bid, G);
        }
        SEAM();
        {
            EpiResidT<false> E{X, XB, SQ(si ^ 1), nullptr}; GEMM_PHASE(EpiResidT<false>, E, CO, wl + WO_CO, MP, DM, 256, bid); SResid F{X, XB, SQ(si ^ 1), nullptr}; STILES_(1, 256, 4, CO, wl + WO_CO, 256, F); si ^= 1;
        }
        SEAM();
        {
            EpiRelu2 E{HID, FF}; GEMM_PHASE(EpiRelu2, E, XB, wl + WO_UP, MT, FF, DM, bid);
        }
        SEAM();
        {
            EpiResidT<true> E{X, XB, SQ(si ^ 1), SQ(si)}; GEMM_PHASE(EpiResidT<true>, E, HID, wl + WO_DN, MP, DM, FF, bid); SResid F{X, XB, SQ(si ^ 1), SQ(si)}; STILES(256, 4, HID, wl + WO_DN, FF, F); si ^= 1;
        }
        SEAM();
    }
    {
        const float* gf = a.in[23];
        int tf = threadIdx.x; asm volatile("" : "+v"(tf)); const int lane = tf & 63, wave = tf >> 6;
        const f32x4* gr = (const f32x4*)gf + lane * 4;
        const f32x4 h0 = gr[0], h1 = gr[1], h2 = gr[2], h3 = gr[3];
        for (int m = bid * 8 + wave; m < MT; m += G * 16) {
            const int m2 = m + G * 8; const bool has2 = m2 < MT; const int mb = has2 ? m2 : m;
            const float rsa = row_rstd(SQ(si), m), rsb = row_rstd(SQ(si), mb);
            const u32x4* pa = (const u32x4*)(XB + (size_t)m * DM) + lane * 2; const u32x4* pb = (const u32x4*)(XB + (size_t)mb * DM) + lane * 2;
            const u32x4 wa0 = pa[0], wa1 = pa[1], wb0 = pb[0], wb1 = pb[1];
            f32x4 a0, a1, a2, a3, b0, b1, b2, b3; unpack8(wa0, a0, a1); unpack8(wa1, a2, a3); unpack8(wb0, b0, b1); unpack8(wb1, b2, b3);
            f32x4* ya = (f32x4*)(X + (size_t)m * DM) + lane * 4; f32x4* yb = (f32x4*)(X + (size_t)mb * DM) + lane * 4;
            ya[0] = a0 * rsa * h0; ya[1] = a1 * rsa * h1; ya[2] = a2 * rsa * h2; ya[3] = a3 * rsa * h3;
            if (has2) { yb[0] = b0 * rsb * h0; yb[1] = b1 * rsb * h1; yb[2] = b2 * rsb * h2; yb[3] = b3 * rsb * h3; }
        }
    }
}

extern "C" void kernel_launch(void* const* d_in, const int* in_sizes, int n_in, void* d_out, int out_size, void* d_ws, size_t ws_size, hipStream_t stream) {
    static int grid = 0;
    if (grid == 0) {
        int dev = 0, cus = 0, per_cu = 0;
        hipGetDevice(&dev);
        hipDeviceGetAttribute(&cus, hipDeviceAttributeMultiprocessorCount, dev);
        hipFuncSetAttribute((const void*)fwd_mega, hipFuncAttributeMaxDynamicSharedMemorySize, LDS_BYTES);
        hipOccupancyMaxActiveBlocksPerMultiprocessor(&per_cu, (const void*)fwd_mega, 512, LDS_BYTES);
        if (per_cu < 1) per_cu = 1;
        grid = cus * per_cu;
        if (ws_size < WS_END) fprintf(stderr, "kernel_launch: workspace too small: %zu < %zu\n", ws_size, (size_t)WS_END);
        (void)hipGetLastError();
    }
    hipMemsetAsync(d_ws, 0, 65536, stream);
    Args a{};
    for (int i = 0; i < 24; ++i) a.in[i] = (const float*)d_in[i];
    a.out = (float*)d_out; a.ws = (unsigned char*)d_ws;
    void* args[] = {&a};
    hipError_t e = hipLaunchCooperativeKernel((const void*)fwd_mega, dim3(grid), dim3(512), args, LDS_BYTES, stream);
    if (e != hipSuccess) fprintf(stderr, "cooperative launch failed: %s (grid %d)\n", hipGetErrorString(e), grid);
}
```

```cpp
#include <hip/hip_runtime.h>
#include <hip/hip_cooperative_groups.h>
#include <cstdio>
#include <cstdint>
namespace cg = cooperative_groups;
namespace pg8 {
#define PG8_LAS __attribute__((address_space(3)))
typedef unsigned short bf16_t;
typedef short bf16x8 __attribute__((ext_vector_type(8)));
typedef float f32x4 __attribute__((ext_vector_type(4)));
typedef unsigned u32x4 __attribute__((ext_vector_type(4)));
constexpr int BM = 256, BK = 64, HALF = 128, HTB = HALF * BK * 2  , STAGE_BYTES = 8 * HTB, NXCD = 8, WGM = 8;

__host__ __device__ __forceinline__ int lds_byte(int r, int c) { const int st = (r >> 4) * 2 + (c >> 5), rr = r & 15, cc = c & 31, ob = rr * 64 + cc * 2; return st * 1024 + (ob ^ (((ob >> 9) & 1) << 5)); }
__host__ __device__ __forceinline__ void stage_rc(int b, int& R, int& C) { const int st = b / 1024, sb = b % 1024, swz = sb ^ (((sb >> 9) & 1) << 5); R = (st >> 1) * 16 + swz / 64; C = (st & 1) * 32 + (swz % 64) / 2; }
__host__ __device__ __forceinline__ int perm32(int rho) { const int n = rho >> 4, i = rho & 15; return 8 * (i >> 2) + 4 * n + (i & 3); }

struct Unit { int pm, pn, half; };
struct Gemm { const bf16_t* A; const bf16_t* Bt; int M, N, K; const bf16_t* A2 = nullptr; const bf16_t* Bt2 = nullptr; };
template <class E, class = void> struct epi_chain_t { static constexpr bool v = false; };
template <class E> struct epi_chain_t<E, decltype((void)E::CHAIN)> { static constexpr bool v = E::CHAIN; };

struct StaticOrder {
    int nM, nN, nwg, G, c;
    __host__ __device__ void init(int M, int N, int G_, int c_) { nM = M / BM; nN = N / BM; nwg = nM * nN; G = G_; c = c_; }
    __host__ __device__ bool next(int i, Unit& u) const {
        const long L = (long)i * G + c; if (L >= nwg) return false;
        int wgid = (int)L; { const int q = nwg / NXCD, r = nwg % NXCD, xcd = wgid % NXCD, off = wgid / NXCD; wgid = (xcd < r ? xcd * (q + 1) : r * (q + 1) + (xcd - r) * q) + off; }
        const int nig = WGM * nN, gid = wgid / nig, fm = gid * WGM, gsz = (nM - fm) < WGM ? (nM - fm) : WGM;
        u.pm = fm + ((wgid % nig) % gsz); u.pn = (wgid % nig) / gsz; return true;
    }
    __device__ __forceinline__ void a_ready(const Unit&) const {}
    __device__ __forceinline__ void done(const Unit&) const {}
};
struct PairOrder {
    StaticOrder S;
    __host__ __device__ void init(int M, int N, int G_, int c_) { S.init(M, N, G_, c_); }
    __host__ __device__ bool next(int i, Unit& u) const { if (!S.next(i >> 1, u)) return false; u.half = i & 1; return true; }
    __device__ __forceinline__ void a_ready(const Unit&) const {}
    __device__ __forceinline__ void done(const Unit&) const {}
};
template <class Epi, class Sched, bool ALIGN_EPI = false, bool SP2 = false>
__device__ __forceinline__ void gemm_phase(PG8_LAS unsigned char* lds, const Gemm g, const Sched& S, const Epi& E) {
    int tid_l = threadIdx.x; asm volatile("" : "+v"(tid_l)); const int tid = tid_l, wid = __builtin_amdgcn_readfirstlane(tid >> 6), lane = tid & 63, wr = wid >> 2, wc = wid & 3, fr = lane & 15, fq = lane >> 4;
    const int K = g.K, nt = K / BK;
    unsigned voffA[2], voffB[2];
#pragma unroll
    for (int i = 0; i < 2; ++i) { int R, C; stage_rc(tid * 16 + i * 8192, R, C); const int Rb = Epi::PERM ? ((R & ~31) + perm32(R & 31)) : R;
        voffA[i] = (unsigned)(R * K + C) * 2u; voffB[i] = (unsigned)(Rb * K + C) * 2u; }
    const size_t kstep = (size_t)(BK * 2);
    const size_t hstep = (size_t)HALF * K * 2;
    const size_t tstep = 2 * hstep;
    const unsigned ldsw = (unsigned)wid * 1024u;
    const int aoff = lds_byte(wr * 64 + fr, fq * 8), boff = lds_byte(wc * 32 + fr, fq * 8);
#define PG8_SA(b, h) (((b) * 2 + (h)) * HTB)
#define PG8_SB(b, h) ((4 + (b) * 2 + (h)) * HTB)
#define PG8_STAGE(bufoff, gbase, voff) do { _Pragma("unroll") for (int _i = 0; _i < 2; ++_i) \
        __builtin_amdgcn_global_load_lds((const unsigned*)((const char*)(gbase) + (voff)[_i]), (PG8_LAS unsigned*)(lds + (bufoff) + ldsw + _i * 8192), 16, 0, 0); } while (0)
#define PG8_LDA(dst, b, h) do { _Pragma("unroll") for (int m = 0; m < 4; ++m) _Pragma("unroll") for (int k = 0; k < 2; ++k) dst[m][k] = *(const PG8_LAS bf16x8*)(lds + PG8_SA(b, h) + aoff + m * 2048 + k * 1024); } while (0)
#define PG8_LDB(dst, b, h) do { _Pragma("unroll") for (int n = 0; n < 2; ++n) _Pragma("unroll") for (int k = 0; k < 2; ++k) dst[n][k] = *(const PG8_LAS bf16x8*)(lds + PG8_SB(b, h) + boff + n * 2048 + k * 1024); } while (0)
#define PG8_MMA(ai, bj, At, Bt) do { __builtin_amdgcn_s_setprio(1); _Pragma("unroll") for (int m = 0; m < 4; ++m) _Pragma("unroll") for (int n = 0; n < 2; ++n) _Pragma("unroll") for (int k = 0; k < 2; ++k) \
        acc[ai][bj][m][n] = __builtin_amdgcn_mfma_f32_16x16x32_bf16(Bt[n][k], At[m][k], acc[ai][bj][m][n], 0, 0, 0); __builtin_amdgcn_s_setprio(0); } while (0)
#define PG8_WAIT_V(n) asm volatile("s_waitcnt vmcnt(" #n ")" ::: "memory")
#define PG8_WAIT_L(n) asm volatile("s_waitcnt lgkmcnt(" #n ")" ::: "memory")
#define PG8_BAR __builtin_amdgcn_s_barrier()
#define PG8_SCHED __builtin_amdgcn_sched_barrier(0)
    Unit cur, nxt; int ui = 0;
    if (!S.next(0, cur)) return;
    f32x4 acc[2][2][4][2];
#pragma unroll
    for (int a = 0; a < 2; ++a)
#pragma unroll
        for (int b = 0; b < 2; ++b)
#pragma unroll
            for (int m = 0; m < 4; ++m)
#pragma unroll
                for (int n = 0; n < 2; ++n) acc[a][b][m][n] = (f32x4){0.f, 0.f, 0.f, 0.f};
    bf16x8 At[4][2], B0[2][2], B1[2][2];
    constexpr bool CH = epi_chain_t<Epi>::v;
    const char* cA = (const char*)g.A + (size_t)cur.pm * tstep; const char* cB = (const char*)g.Bt + (size_t)cur.pn * tstep;
    if constexpr (CH) { if (cur.half) { cA = (const char*)g.A2 + (size_t)cur.pm * tstep; cB = (const char*)g.Bt2 + (size_t)cur.pn * tstep; } }
    S.a_ready(cur);
    if constexpr (SP2) {
        PG8_STAGE(PG8_SB(0, 0), cB, voffB); PG8_STAGE(PG8_SB(0, 1), cB + hstep, voffB); PG8_STAGE(PG8_SA(0, 0), cA, voffA); PG8_STAGE(PG8_SA(0, 1), cA + hstep, voffA);
        if (wr == 1) PG8_BAR;
        PG8_WAIT_V(2); PG8_BAR;
        PG8_STAGE(PG8_SB(1, 0), cB + kstep, voffB); PG8_STAGE(PG8_SA(1, 0), cA + kstep, voffA); PG8_STAGE(PG8_SB(1, 1), cB + hstep + kstep, voffB);
        PG8_WAIT_V(6); PG8_BAR;
    } else {
        PG8_STAGE(PG8_SB(0, 0), cB, voffB); PG8_STAGE(PG8_SA(0, 0), cA, voffA); PG8_STAGE(PG8_SB(0, 1), cB + hstep, voffB); PG8_STAGE(PG8_SA(0, 1), cA + hstep, voffA);
        if (wr == 1) PG8_BAR;
        PG8_WAIT_V(4); PG8_BAR;
        PG8_STAGE(PG8_SB(1, 0), cB + kstep, voffB); PG8_STAGE(PG8_SA(1, 0), cA + kstep, voffA); PG8_STAGE(PG8_SB(1, 1), cB + hstep + kstep, voffB);
        PG8_WAIT_V(6); PG8_BAR;
    }
    for (;;) {
        const bool has_next = S.next(ui + 1, nxt);
        const char* nA = has_next ? (const char*)g.A + (size_t)nxt.pm * tstep : cA; const char* nB = has_next ? (const char*)g.Bt + (size_t)nxt.pn * tstep : cB;
        if constexpr (CH) { if (has_next && nxt.half) { nA = (const char*)g.A2 + (size_t)nxt.pm * tstep; nB = (const char*)g.Bt2 + (size_t)nxt.pn * tstep; } }
        for (int t = 0; t < nt; t += 2) {
            const bool last = (t == nt - 2);
            const char* a1 = cA + (size_t)(t + 1) * kstep;
            const char* a2 = last ? nA : cA + (size_t)(t + 2) * kstep; const char* b2 = last ? nB : cB + (size_t)(t + 2) * kstep;
            const char* a3 = a2 + kstep; const char* b3 = b2 + kstep;
            if (last && has_next) S.a_ready(nxt);
            if constexpr (SP2) {
            PG8_LDB(B0, 0, 0); PG8_LDB(B1, 0, 1); PG8_SCHED; PG8_LDA(At, 0, 0); PG8_STAGE(PG8_SA(1, 1), a1 + hstep, voffA);
            PG8_WAIT_V(8); PG8_WAIT_L(0); PG8_BAR; PG8_MMA(0, 0, At, B0); PG8_MMA(0, 1, At, B1); PG8_BAR; PG8_SCHED;
            PG8_LDA(At, 0, 1); PG8_STAGE(PG8_SB(0, 0), b2, voffB); PG8_STAGE(PG8_SB(0, 1), b2 + hstep, voffB); PG8_STAGE(PG8_SA(0, 0), a2, voffA);
            PG8_WAIT_V(8); PG8_WAIT_L(0); PG8_BAR; PG8_MMA(1, 0, At, B0); PG8_MMA(1, 1, At, B1); PG8_BAR; PG8_SCHED;
            PG8_LDB(B0, 1, 0); PG8_LDB(B1, 1, 1); PG8_SCHED; PG8_LDA(At, 1, 0); PG8_STAGE(PG8_SA(0, 1), a2 + hstep, voffA);
            PG8_WAIT_V(8); PG8_WAIT_L(0); PG8_BAR; PG8_MMA(0, 0, At, B0); PG8_MMA(0, 1, At, B1); PG8_BAR; PG8_SCHED;
            PG8_LDA(At, 1, 1); PG8_STAGE(PG8_SB(1, 0), b3, voffB); PG8_STAGE(PG8_SB(1, 1), b3 + hstep, voffB); PG8_STAGE(PG8_SA(1, 0), a3, voffA);
            PG8_WAIT_V(8); PG8_WAIT_L(0); PG8_BAR; PG8_MMA(1, 0, At, B0); PG8_MMA(1, 1, At, B1); PG8_BAR; PG8_SCHED;
            } else {
            PG8_LDB(B0, 0, 0); PG8_SCHED; PG8_LDA(At, 0, 0); PG8_STAGE(PG8_SA(1, 1), a1 + hstep, voffA);
            PG8_WAIT_L(8); PG8_BAR; PG8_WAIT_L(0); PG8_MMA(0, 0, At, B0); PG8_BAR; PG8_SCHED;
            PG8_LDB(B1, 0, 1); PG8_STAGE(PG8_SB(0, 0), b2, voffB);
            PG8_BAR; PG8_WAIT_L(0); PG8_MMA(0, 1, At, B1); PG8_BAR;
            PG8_LDA(At, 0, 1); PG8_STAGE(PG8_SA(0, 0), a2, voffA);
            PG8_BAR; PG8_WAIT_L(0); PG8_MMA(1, 0, At, B0); PG8_BAR; PG8_SCHED;
            PG8_STAGE(PG8_SB(0, 1), b2 + hstep, voffB);
            PG8_WAIT_V(6); PG8_BAR; PG8_MMA(1, 1, At, B1); PG8_BAR;
            PG8_LDB(B0, 1, 0); PG8_SCHED; PG8_LDA(At, 1, 0); PG8_STAGE(PG8_SA(0, 1), a2 + hstep, voffA);
            PG8_WAIT_L(8); PG8_BAR; PG8_WAIT_L(0); PG8_MMA(0, 0, At, B0); PG8_BAR; PG8_SCHED;
            PG8_LDB(B1, 1, 1); PG8_STAGE(PG8_SB(1, 0), b3, voffB);
            PG8_BAR; PG8_WAIT_L(0); PG8_MMA(0, 1, At, B1); PG8_BAR;
            PG8_LDA(At, 1, 1); PG8_STAGE(PG8_SA(1, 0), a3, voffA);
            PG8_BAR; PG8_WAIT_L(0); PG8_MMA(1, 0, At, B0); PG8_BAR; PG8_SCHED;
            PG8_STAGE(PG8_SB(1, 1), b3 + hstep, voffB);
            PG8_WAIT_V(6); PG8_BAR; PG8_MMA(1, 1, At, B1); PG8_BAR;
            }
        }
        if constexpr (ALIGN_EPI) { if (wr == 0) PG8_BAR; }
        if constexpr (!Epi::AFTER_DRAIN) { E(acc, cur, wr, wc, fr, fq); S.done(cur); }
        if (!has_next) break;
        if (!(CH && cur.half == 0)) {
#pragma unroll
        for (int a = 0; a < 2; ++a)
#pragma unroll
            for (int b = 0; b < 2; ++b)
#pragma unroll
                for (int m = 0; m < 4; ++m)
#pragma unroll
                    for (int n = 0; n < 2; ++n) acc[a][b][m][n] = (f32x4){0.f, 0.f, 0.f, 0.f};
        }
        cur = nxt; cA = nA; cB = nB; ++ui;
        if constexpr (ALIGN_EPI) { if (wr == 1) PG8_BAR; }
    }
    PG8_WAIT_V(0);
    if constexpr (!ALIGN_EPI) { if (wr == 0) PG8_BAR; }
    PG8_BAR;
    if constexpr (Epi::AFTER_DRAIN) { E.fused(acc, cur, wr, wc, fr, fq, lds, wid, lane); S.done(cur); }
#undef PG8_SA
#undef PG8_SB
#undef PG8_STAGE
#undef PG8_LDA
#undef PG8_LDB
#undef PG8_MMA
#undef PG8_WAIT_V
#undef PG8_WAIT_L
#undef PG8_BAR
#undef PG8_SCHED
}
}

#define LAS __attribute__((address_space(3)))
typedef unsigned short bf16_t;
typedef short bf16x8 __attribute__((ext_vector_type(8)));
typedef short s16x4 __attribute__((ext_vector_type(4)));
typedef float f32x4 __attribute__((ext_vector_type(4)));
typedef float f32x16 __attribute__((ext_vector_type(16)));
typedef unsigned u32x4 __attribute__((ext_vector_type(4)));
typedef unsigned u32x2 __attribute__((ext_vector_type(2)));
typedef float f32x2_t __attribute__((ext_vector_type(2)));
typedef __bf16 bf16x2_t __attribute__((ext_vector_type(2)));

constexpr int DM = 1024, MP = 16384, MS = 1024, MT = MP + MS, NIN = 6656, FF = 4096, DEPTH = 4;
constexpr int SEQ = 2048, NB = 8, DB = 32, DSQ = 32;
constexpr float EPS = 1e-6f;
constexpr float LOG2E = 1.4426950408889634f;
constexpr size_t MiB = 1u << 20;
constexpr size_t WO_IN = 0, WO_AO = WO_IN + (size_t)NIN * DM, WO_CV = WO_AO + (size_t)DM * DM, WO_MIX = WO_CV + (size_t)DM * DM,
                 WO_CQ = WO_MIX + (size_t)DM * DM, WO_CKV = WO_CQ + (size_t)256 * DM, WO_CO = WO_CKV + (size_t)512 * DM,
                 WO_UP = WO_CO + (size_t)DM * 256, WO_DN = WO_UP + (size_t)FF * DM, W_LAYER = WO_DN + (size_t)DM * FF;
constexpr size_t WS_W = 1 * MiB, WS_XB = 150 * MiB, WS_SSQ = 184 * MiB, WS_MEMN = 186 * MiB, WS_MKV = 190 * MiB, WS_CQ = 198 * MiB, WS_CO = 207 * MiB,
                 WS_ZQ = 216 * MiB, WS_ZKV = 250 * MiB, WS_ZCH = 267 * MiB, WS_ZCB = 301 * MiB, WS_ZCC = 335 * MiB, WS_ZGA = 369 * MiB, WS_ZGB = 403 * MiB, WS_END = 437 * MiB;
constexpr size_t WS_HID = WS_ZQ;
static_assert(WS_W + W_LAYER * 2 * DEPTH <= WS_XB, "weights fit");
static_assert(WS_HID + (size_t)MT * FF * 2 <= WS_ZGA, "hid overlay");
constexpr size_t O_Y = 0, O_KP = 17825792, O_VP = 18874368, O_CP = 19922944, O_MKP = 19988480, O_MVP = 22085632, O_KS = 24182784, O_VS = 25231360, O_CS = 26279936;

__device__ __forceinline__ unsigned cvtpk(float lo, float hi) { f32x2_t v = {lo, hi}; bf16x2_t b = __builtin_convertvector(v, bf16x2_t); return __builtin_bit_cast(unsigned, b); }
__device__ __forceinline__ float bf2f(unsigned short b) { return __uint_as_float(((unsigned)b) << 16); }
__device__ __forceinline__ float bflo(unsigned w) { return __uint_as_float(w << 16); }
__device__ __forceinline__ float bfhi(unsigned w) { return __uint_as_float(w & 0xffff0000u); }
__device__ __forceinline__ float sigmoidf_(float x) { return __builtin_amdgcn_rcpf(1.0f + __builtin_amdgcn_exp2f(-x * LOG2E)); }
__device__ __forceinline__ float wave_sum(float v) {
#pragma unroll
    for (int o = 1; o < 64; o <<= 1) v += __shfl_xor(v, o);
    return v;
}
__device__ __forceinline__ float row_rstd(const float* ssq, int row) {
    const f32x4* p = (const f32x4*)(ssq + (size_t)row * 16);
    const f32x4 a = p[0], b = p[1], c = p[2], d = p[3];
    const float s = ((a[0] + a[1]) + (a[2] + a[3])) + ((b[0] + b[1]) + (b[2] + b[3])) + ((c[0] + c[1]) + (c[2] + c[3])) + ((d[0] + d[1]) + (d[2] + d[3]));
    return rsqrtf(s * (1.0f / DM) + EPS);
}
__device__ __forceinline__ float row_rstd_q(const float* ssq, int row, int fq) {
    const f32x4 a = *(const f32x4*)(ssq + (size_t)row * 16 + fq * 4);
    float s = (a[0] + a[1]) + (a[2] + a[3]);
    s += __shfl_xor(s, 16); s += __shfl_xor(s, 32);
    return rsqrtf(s * (1.0f / DM) + EPS);
}
__device__ __forceinline__ u32x4 pack8(const f32x4 v0, const f32x4 v1) { u32x4 w; w.x = cvtpk(v0[0], v0[1]); w.y = cvtpk(v0[2], v0[3]); w.z = cvtpk(v1[0], v1[1]); w.w = cvtpk(v1[2], v1[3]); return w; }
__device__ __forceinline__ void unpack8(const u32x4 w, f32x4& v0, f32x4& v1) { v0 = (f32x4){bflo(w.x), bfhi(w.x), bflo(w.y), bfhi(w.y)}; v1 = (f32x4){bflo(w.z), bfhi(w.z), bflo(w.w), bfhi(w.w)}; }

typedef f32x4 acc_t[2][2][4][2];
#define EPI_LOOP_ROWS for (int ai = 0; ai < 2; ++ai) _Pragma("unroll") for (int m = 0; m < 4; ++m)

struct EpiZ {
    static constexpr bool PERM = true, AFTER_DRAIN = false;
    bf16_t *zq, *zkv, *zch, *zcb, *zcc, *zga, *zgb; const float* ssq; float *okp, *ovp, *oks, *ovs;
    __device__ __forceinline__ void operator()(const acc_t& acc, const pg8::Unit& u, int wr, int wc, int fr0, int fq0) const {
        int fr = fr0, fq = fq0; asm volatile("" : "+v"(fr), "+v"(fq));
        const int pn = u.pn; bf16_t* base; int ldc, c0;
        if (pn < 4) { base = zq; ldc = 1024; c0 = pn * 256; }
        else if (pn < 6) { base = zkv; ldc = 512; c0 = (pn - 4) * 256; }
        else if (pn < 14) { base = zch; ldc = 1024; c0 = (pn - 6) * 128; }
        else { const int t = (pn - 14) >> 2; base = (bf16_t*)((unsigned char*)zcb + (size_t)t * (WS_ZGA - WS_ZCB) - (t == 2 ? (2 * (WS_ZGA - WS_ZCB) - (WS_ZGB - WS_ZCB)) : 0)); ldc = 1024; c0 = ((pn - 14) & 3) * 256; }
        float* fo = nullptr; int fo_ai_min = 0;
        if (pn == 4 || pn == 5) {
            if (u.pm >= 64) { fo = (pn == 4 ? oks : ovs) + (size_t)(u.pm - 64) * 256 * 256; }
            else if ((u.pm & 7) == 7) { fo = (pn == 4 ? okp : ovp) + (size_t)(u.pm >> 3) * 128 * 256 - 128 * 256; fo_ai_min = 1; }
        }
        const int colw = wc * 32 + 8 * fq;
        float rsv[2][4];
#pragma unroll
        EPI_LOOP_ROWS rsv[ai][m] = row_rstd_q(ssq, u.pm * 256 + ai * 128 + wr * 64 + m * 16 + fr, fq);
#pragma unroll
        EPI_LOOP_ROWS {
            const int rl = ai * 128 + wr * 64 + m * 16 + fr, row = u.pm * 256 + rl;
            const float rs = rsv[ai][m];
            if (pn >= 6 && pn < 14) {
                const float rs2 = rs * rs;
                const f32x4 v0 = acc[ai][0][m][0] * acc[ai][1][m][0] * rs2, v1 = acc[ai][0][m][1] * acc[ai][1][m][1] * rs2;
                *(u32x4*)(base + (size_t)row * ldc + c0 + colw) = pack8(v0, v1);
            } else {
#pragma unroll
            for (int bj = 0; bj < 2; ++bj) {
                const f32x4 v0 = acc[ai][bj][m][0] * rs, v1 = acc[ai][bj][m][1] * rs;
                const int cl = bj * 128 + colw;
                *(u32x4*)(base + (size_t)row * ldc + c0 + cl) = pack8(v0, v1);
                if (fo && ai >= fo_ai_min) { float* p = fo + (size_t)rl * 256 + cl; *(f32x4*)p = v0; *(f32x4*)(p + 4) = v1; }
            }
            }
        }
    }
};
struct EpiGate1 {
    static constexpr bool PERM = true, AFTER_DRAIN = false;
    bf16_t* zga;
    __device__ __forceinline__ void operator()(const acc_t& acc, const pg8::Unit& u, int wr, int wc, int fr0, int fq0) const {
        int fr = fr0, fq = fq0; asm volatile("" : "+v"(fr), "+v"(fq));
        const int colw = u.pn * 256 + wc * 32 + 8 * fq;
#pragma unroll
        for (int ai = 0; ai < 2; ++ai) {
            u32x4 gw[4][2];
#pragma unroll
            for (int m = 0; m < 4; ++m)
#pragma unroll
                for (int bj = 0; bj < 2; ++bj) gw[m][bj] = *(const u32x4*)(zga + (size_t)(u.pm * 256 + ai * 128 + wr * 64 + m * 16 + fr) * 1024 + colw + bj * 128);
#pragma unroll
            for (int m = 0; m < 4; ++m)
#pragma unroll
                for (int bj = 0; bj < 2; ++bj) {
                    f32x4 g0, g1; unpack8(gw[m][bj], g0, g1);
                    f32x4 v0 = acc[ai][bj][m][0], v1 = acc[ai][bj][m][1];
#pragma unroll
                    for (int e = 0; e < 4; ++e) { v0[e] *= sigmoidf_(g0[e]); v1[e] *= sigmoidf_(g1[e]); }
                    *(u32x4*)(zga + (size_t)(u.pm * 256 + ai * 128 + wr * 64 + m * 16 + fr) * 1024 + colw + bj * 128) = pack8(v0, v1);
                }
        }
    }
};
struct EpiGate2 {
    static constexpr bool PERM = true, AFTER_DRAIN = false;
    bf16_t* zga; const bf16_t* zgb;
    __device__ __forceinline__ void operator()(const acc_t& acc, const pg8::Unit& u, int wr, int wc, int fr0, int fq0) const {
        int fr = fr0, fq = fq0; asm volatile("" : "+v"(fr), "+v"(fq));
        const int colw = u.pn * 256 + wc * 32 + 8 * fq;
#pragma unroll
        for (int ai = 0; ai < 2; ++ai) {
            u32x4 tw[4][2], gw[4][2];
#pragma unroll
            for (int m = 0; m < 4; ++m)
#pragma unroll
                for (int bj = 0; bj < 2; ++bj) { const size_t off = (size_t)(u.pm * 256 + ai * 128 + wr * 64 + m * 16 + fr) * 1024 + colw + bj * 128;
                    tw[m][bj] = *(const u32x4*)(zga + off); gw[m][bj] = *(const u32x4*)(zgb + off); }
#pragma unroll
            for (int m = 0; m < 4; ++m)
#pragma unroll
                for (int bj = 0; bj < 2; ++bj) {
                    const size_t off = (size_t)(u.pm * 256 + ai * 128 + wr * 64 + m * 16 + fr) * 1024 + colw + bj * 128;
                    f32x4 t0, t1, g0, g1; unpack8(tw[m][bj], t0, t1); unpack8(gw[m][bj], g0, g1);
                    f32x4 v0 = acc[ai][bj][m][0], v1 = acc[ai][bj][m][1];
#pragma unroll
                    for (int e = 0; e < 4; ++e) { v0[e] = t0[e] + v0[e] * sigmoidf_(g0[e]); v1[e] = t1[e] + v1[e] * sigmoidf_(g1[e]); }
                    *(u32x4*)(zga + off) = pack8(v0, v1);
                }
        }
    }
};
struct EpiGatePair {
    static constexpr bool PERM = true, AFTER_DRAIN = false, CHAIN = true;
    bf16_t* zga; const bf16_t* zgb;
    __device__ __forceinline__ void operator()(f32x4 (&acc)[2][2][4][2], const pg8::Unit& u, int wr, int wc, int fr0, int fq0) const {
        int fr = fr0, fq = fq0; asm volatile("" : "+v"(fr), "+v"(fq));
        const int colw = u.pn * 256 + wc * 32 + 8 * fq;
        if (u.half == 0) {
#pragma unroll
            for (int ai = 0; ai < 2; ++ai) {
                u32x4 aw[4][2], gw[4][2];
#pragma unroll
                for (int m = 0; m < 4; ++m)
#pragma unroll
                    for (int bj = 0; bj < 2; ++bj) { const size_t off = (size_t)(u.pm * 256 + ai * 128 + wr * 64 + m * 16 + fr) * 1024 + colw + bj * 128;
                        aw[m][bj] = *(const u32x4*)(zga + off); gw[m][bj] = *(const u32x4*)(zgb + off); }
#pragma unroll
                for (int m = 0; m < 4; ++m)
#pragma unroll
                    for (int bj = 0; bj < 2; ++bj) {
                        f32x4 a0, a1, g0, g1; unpack8(aw[m][bj], a0, a1); unpack8(gw[m][bj], g0, g1);
#pragma unroll
                        for (int e = 0; e < 4; ++e) {
                            acc[ai][bj][m][0][e] *= (1.0f + __builtin_amdgcn_exp2f(-g0[e] * LOG2E)) * __builtin_amdgcn_rcpf(1.0f + __builtin_amdgcn_exp2f(-a0[e] * LOG2E));
                            acc[ai][bj][m][1][e] *= (1.0f + __builtin_amdgcn_exp2f(-g1[e] * LOG2E)) * __builtin_amdgcn_rcpf(1.0f + __builtin_amdgcn_exp2f(-a1[e] * LOG2E));
                        }
                    }
            }
        } else {
#pragma unroll
            for (int ai = 0; ai < 2; ++ai) {
                u32x4 gw[4][2];
#pragma unroll
                for (int m = 0; m < 4; ++m)
#pragma unroll
                    for (int bj = 0; bj < 2; ++bj) gw[m][bj] = *(const u32x4*)(zgb + (size_t)(u.pm * 256 + ai * 128 + wr * 64 + m * 16 + fr) * 1024 + colw + bj * 128);
#pragma unroll
                for (int m = 0; m < 4; ++m)
#pragma unroll
                    for (int bj = 0; bj < 2; ++bj) {
                        f32x4 g0, g1; unpack8(gw[m][bj], g0, g1);
                        f32x4 v0 = acc[ai][bj][m][0], v1 = acc[ai][bj][m][1];
#pragma unroll
                        for (int e = 0; e < 4; ++e) { v0[e] *= sigmoidf_(g0[e]); v1[e] *= sigmoidf_(g1[e]); }
                        *(u32x4*)(zga + (size_t)(u.pm * 256 + ai * 128 + wr * 64 + m * 16 + fr) * 1024 + colw + bj * 128) = pack8(v0, v1);
                    }
            }
        }
    }
};
template <bool SCALE> struct EpiResidT {
    static constexpr bool PERM = true, AFTER_DRAIN = false;
    float* x; bf16_t* xb; float* ssq; const float* ssq_in;
    __device__ __forceinline__ void operator()(const acc_t& acc, const pg8::Unit& u, int wr, int wc, int fr0, int fq0) const {
        int fr = fr0, fq = fq0; asm volatile("" : "+v"(fr), "+v"(fq));
        const int colw = u.pn * 256 + wc * 32 + 8 * fq;
#pragma unroll
        for (int ai = 0; ai < 2; ++ai) {
            u32x4 xr[4][2]; float rs2[4];
#pragma unroll
            for (int m = 0; m < 4; ++m) {
                const int row = u.pm * 256 + ai * 128 + wr * 64 + m * 16 + fr;
#pragma unroll
                for (int bj = 0; bj < 2; ++bj) xr[m][bj] = *(const u32x4*)(xb + (size_t)row * 1024 + colw + bj * 128);
                if (SCALE) { const float r_ = row_rstd_q(ssq_in, row, fq); rs2[m] = r_ * r_; } else rs2[m] = 1.f;
            }
#pragma unroll
            for (int m = 0; m < 4; ++m) {
                const int row = u.pm * 256 + ai * 128 + wr * 64 + m * 16 + fr;
                float sq = 0.f;
#pragma unroll
                for (int bj = 0; bj < 2; ++bj) {
                    const size_t off = (size_t)row * 1024 + colw + bj * 128;
                    f32x4 x0, x1; unpack8(xr[m][bj], x0, x1);
                    const f32x4 v0 = SCALE ? x0 + acc[ai][bj][m][0] * rs2[m] : x0 + acc[ai][bj][m][0],
                                v1 = SCALE ? x1 + acc[ai][bj][m][1] * rs2[m] : x1 + acc[ai][bj][m][1];
                    *(u32x4*)(xb + off) = pack8(v0, v1);
                    sq += (v0[0] * v0[0] + v0[1] * v0[1]) + (v0[2] * v0[2] + v0[3] * v0[3]) + (v1[0] * v1[0] + v1[1] * v1[1]) + (v1[2] * v1[2] + v1[3] * v1[3]);
                }
                sq += __shfl_xor(sq, 16); sq += __shfl_xor(sq, 32);
                if (fq == 0) ssq[(size_t)row * 16 + u.pn * 4 + wc] = sq;
            }
        }
    }
};
template <int ACT> struct EpiScale {
    static constexpr bool PERM = true, AFTER_DRAIN = false;
    bf16_t* o; int ldc; const float* ssq;
    __device__ __forceinline__ void operator()(const acc_t& acc, const pg8::Unit& u, int wr, int wc, int fr0, int fq0) const {
        int fr = fr0, fq = fq0; asm volatile("" : "+v"(fr), "+v"(fq));
        const int colw = u.pn * 256 + wc * 32 + 8 * fq;
        float rsv[2][4];
#pragma unroll
        EPI_LOOP_ROWS rsv[ai][m] = row_rstd_q(ssq, u.pm * 256 + ai * 128 + wr * 64 + m * 16 + fr, fq);
#pragma unroll
        EPI_LOOP_ROWS {
            const int row = u.pm * 256 + ai * 128 + wr * 64 + m * 16 + fr;
            const float rs = rsv[ai][m];
#pragma unroll
            for (int bj = 0; bj < 2; ++bj) {
                f32x4 v0 = acc[ai][bj][m][0] * rs, v1 = acc[ai][bj][m][1] * rs;
                if (ACT == 1) {
#pragma unroll
                    for (int e = 0; e < 4; ++e) { const float a = fmaxf(v0[e], 0.f), b = fmaxf(v1[e], 0.f); v0[e] = a * a; v1[e] = b * b; }
                }
                *(u32x4*)(o + (size_t)row * ldc + colw + bj * 128) = pack8(v0, v1);
            }
        }
    }
};
struct EpiRelu2 {
    static constexpr bool PERM = true, AFTER_DRAIN = false;
    bf16_t* o; int ldc;
    __device__ __forceinline__ void operator()(const acc_t& acc, const pg8::Unit& u, int wr, int wc, int fr0, int fq0) const {
        int fr = fr0, fq = fq0; asm volatile("" : "+v"(fr), "+v"(fq));
        const int colw = u.pn * 256 + wc * 32 + 8 * fq;
#pragma unroll
        EPI_LOOP_ROWS {
            const int row = u.pm * 256 + ai * 128 + wr * 64 + m * 16 + fr;
#pragma unroll
            for (int bj = 0; bj < 2; ++bj) {
                f32x4 v0 = acc[ai][bj][m][0], v1 = acc[ai][bj][m][1];
#pragma unroll
                for (int e = 0; e < 4; ++e) { const float a = fmaxf(v0[e], 0.f), b = fmaxf(v1[e], 0.f); v0[e] = a * a; v1[e] = b * b; }
                *(u32x4*)(o + (size_t)row * ldc + colw + bj * 128) = pack8(v0, v1);
            }
        }
    }
};
struct EpiMemKV {
    static constexpr bool PERM = true, AFTER_DRAIN = false;
    bf16_t* mkv; float *ok, *ov;
    __device__ __forceinline__ void operator()(const acc_t& acc, const pg8::Unit& u, int wr, int wc, int fr0, int fq0) const {
        int fr = fr0, fq = fq0; asm volatile("" : "+v"(fr), "+v"(fq));
        const int colw = wc * 32 + 8 * fq; float* fo = u.pn == 0 ? ok : ov;
#pragma unroll
        EPI_LOOP_ROWS {
            const int row = u.pm * 256 + ai * 128 + wr * 64 + m * 16 + fr;
#pragma unroll
            for (int bj = 0; bj < 2; ++bj) {
                const f32x4 v0 = acc[ai][bj][m][0], v1 = acc[ai][bj][m][1];
                const int cl = colw + bj * 128;
                *(u32x4*)(mkv + (size_t)row * 512 + u.pn * 256 + cl) = pack8(v0, v1);
                float* p = fo + (size_t)row * 256 + cl; *(f32x4*)p = v0; *(f32x4*)(p + 4) = v1;
            }
        }
    }
};

#define MFMA32(a, b, c) __builtin_amdgcn_mfma_f32_32x32x16_bf16((a), (b), (c), 0, 0, 0)
typedef short v4i16_t __attribute__((ext_vector_type(4)));
constexpr int AT_KP = 144, AT_VP = 192;
__device__ __forceinline__ int crow(int r, int h) { return (r & 3) + 8 * (r >> 2) + 4 * h; }
__device__ __forceinline__ s16x4 vtr(const LAS unsigned char* p) { return __builtin_bit_cast(s16x4, __builtin_amdgcn_ds_read_tr16_b64_v4i16((LAS v4i16_t*)p)); }
template <int MAXKB, int NPASS, bool ALIBI, bool FULL = false>
__device__ __forceinline__ void attn_core(const LAS unsigned char* Ks, const LAS unsigned char* Vs, int nkb, const bf16x8 (&qf)[4], bf16_t* optr,
                                          float scale2, float slope2, float sink2, int qrel, int lane) {
    const int r32 = lane & 31, h = lane >> 5;
    const LAS unsigned char* kbase = Ks + r32 * AT_KP + 16 * h;
    const LAS unsigned char* vbase = Vs + (4 * h + ((lane & 15) >> 2)) * AT_VP + 32 * ((lane >> 4) & 1) + 8 * (lane & 3);
    float m_run = ALIBI ? sink2 : -3.0e38f, l = 0.f;
    const float qd = (float)(qrel - 4 * h);
    f32x16 o0, o1;
#pragma unroll
    for (int i = 0; i < 16; ++i) { o0[i] = 0.f; o1[i] = 0.f; }
#pragma unroll
    for (int pass = 0; pass < NPASS; ++pass) {
        f32x16 st[MAXKB];
#pragma unroll
        for (int kk = 0; kk < MAXKB; ++kk) {
            const int kb = pass * MAXKB + kk;
#pragma unroll
            for (int i = 0; i < 16; ++i) st[kk][i] = 0.f;
            if (FULL || kb < nkb) {
#pragma unroll
                for (int ds = 0; ds < 4; ++ds) {
                    const bf16x8 kf = *(const LAS bf16x8*)(kbase + kb * 32 * AT_KP + 32 * ds);
                    st[kk] = MFMA32(kf, qf[ds], st[kk]);
                }
            }
        }
        float mx = m_run;
#pragma unroll
        for (int kk = 0; kk < MAXKB; ++kk) { const int kb = pass * MAXKB + kk; if (FULL || kb < nkb) {
#pragma unroll
            for (int i = 0; i < 16; ++i) {
                float s = st[kk][i] * scale2;
                if (ALIBI) s -= slope2 * fabsf(qd - (float)(kb * 32 + (i & 3) + 8 * (i >> 2)));
                st[kk][i] = s; mx = fmaxf(mx, s);
            } } }
        mx = fmaxf(mx, __shfl_xor(mx, 32));
        if (pass > 0) { const float corr = __builtin_amdgcn_exp2f(m_run - mx); l *= corr;
#pragma unroll
            for (int i = 0; i < 16; ++i) { o0[i] *= corr; o1[i] *= corr; } }
        m_run = mx;
#pragma unroll
        for (int kk = 0; kk < MAXKB; ++kk) { const int kb = pass * MAXKB + kk; if (FULL || kb < nkb) {
#pragma unroll
            for (int i = 0; i < 16; ++i) { const float p = __builtin_amdgcn_exp2f(st[kk][i] - mx); st[kk][i] = p; l += p; } } }
#pragma unroll
        for (int kk = 0; kk < MAXKB; ++kk) { const int kb = pass * MAXKB + kk; if (FULL || kb < nkb) {
#pragma unroll
            for (int s = 0; s < 2; ++s) {
                u32x4 pw; pw.x = cvtpk(st[kk][8 * s + 0], st[kk][8 * s + 1]); pw.y = cvtpk(st[kk][8 * s + 2], st[kk][8 * s + 3]);
                pw.z = cvtpk(st[kk][8 * s + 4], st[kk][8 * s + 5]); pw.w = cvtpk(st[kk][8 * s + 6], st[kk][8 * s + 7]);
                const bf16x8 xs = __builtin_bit_cast(bf16x8, pw);
                const LAS unsigned char* vp = vbase + (kb * 32 + 16 * s) * AT_VP;
                {
                    const s16x4 lo = vtr(vp), hi = vtr(vp + 8 * AT_VP);
                    o0 = MFMA32(__builtin_shufflevector(lo, hi, 0, 1, 2, 3, 4, 5, 6, 7), xs, o0);
                }
                {
                    const s16x4 lo = vtr(vp + 64), hi = vtr(vp + 8 * AT_VP + 64);
                    o1 = MFMA32(__builtin_shufflevector(lo, hi, 0, 1, 2, 3, 4, 5, 6, 7), xs, o1);
                }
            } } }
    }
    l += __shfl_xor(l, 32);
    if (ALIBI) l += __builtin_amdgcn_exp2f(sink2 - m_run);
    const float rl = 1.0f / l;
#pragma unroll
    for (int g = 0; g < 4; ++g) {
        u32x2 w0, w1;
        w0.x = cvtpk(o0[4 * g] * rl, o0[4 * g + 1] * rl); w0.y = cvtpk(o0[4 * g + 2] * rl, o0[4 * g + 3] * rl);
        w1.x = cvtpk(o1[4 * g] * rl, o1[4 * g + 1] * rl); w1.y = cvtpk(o1[4 * g + 2] * rl, o1[4 * g + 3] * rl);
        *(u32x2*)(optr + 8 * g + 4 * h) = w0;
        *(u32x2*)(optr + 32 + 8 * g + 4 * h) = w1;
    }
}

__device__ __forceinline__ bf16x8 cvt8(const float* p) { const f32x4 a = *(const f32x4*)p, b = *(const f32x4*)(p + 4); return __builtin_bit_cast(bf16x8, pack8(a, b)); }
template <int NIT> __device__ __forceinline__ void kv_store(LAS unsigned char* Ks, LAS unsigned char* Vs, int nk8, int tid, const bf16x8 (&kr)[NIT], const bf16x8 (&vr)[NIT]) {
#pragma unroll
    for (int it = 0; it < NIT; ++it) { const int idx = tid + it * 512; if (idx < nk8) { const int key = idx >> 3, ch = idx & 7;
        *(LAS bf16x8*)(Ks + key * AT_KP + ch * 16) = kr[it]; *(LAS bf16x8*)(Vs + key * AT_VP + ch * 16) = vr[it]; } }
}
constexpr int SW_VS_OFF = 192 * AT_KP, XA_VS_OFF = 256 * AT_KP;
constexpr int N_SWA_UNITS = NB * 32 * 4 + DB * 4;
constexpr int N_XA_UNITS = NB * 4 * 8 + DB * 4;

struct SwaUnit { int nk, nq, qrow0, krow0, kvh, b; };
__device__ __forceinline__ void swa_decode(int unit, SwaUnit& U) {
    if (unit < 1024) { const int b = unit >> 7, c = (unit >> 2) & 31, back = c < 2 ? c : 2; U.kvh = unit & 3; U.b = b; U.nk = (back + 1) * 64; U.nq = 64; U.qrow0 = b * SEQ + c * 64; U.krow0 = U.qrow0 - back * 64; }
    else { const int su = unit - 1024; U.b = su >> 2; U.kvh = su & 3; U.nk = 160; U.nq = 32; U.qrow0 = MP + U.b * 32; U.krow0 = U.qrow0 - 128; }
}
__device__ __forceinline__ void swa_load(const SwaUnit& U, int l, const bf16_t* zkv, const float* cak, const float* cav, int tid, bf16x8 (&kr)[3], bf16x8 (&vr)[3]) {
#pragma unroll
    for (int it = 0; it < 3; ++it) { const int idx = tid + it * 512; if (idx < U.nk * 8) { const int key = idx >> 3, ch = idx & 7;
        if (U.nq == 32 && key < 128) { const size_t off = ((((size_t)l * DB + U.b) * 128 + key) * 4 + U.kvh) * 64 + ch * 8; kr[it] = cvt8(cak + off); vr[it] = cvt8(cav + off); }
        else { const bf16_t* p = zkv + (size_t)(U.krow0 + key) * 512 + U.kvh * 64 + ch * 8; kr[it] = *(const bf16x8*)p; vr[it] = *(const bf16x8*)(p + 256); } } }
}
__device__ __forceinline__ void swa_phase(int l, LAS unsigned char* lds, bf16_t* zq, const bf16_t* zkv, const float* cak, const float* cav, const float* sinks, int tid, int bid, int G) {
    LAS unsigned char* Ks = lds; LAS unsigned char* Vs = lds + SW_VS_OFF;
    bf16x8 kr[3], vr[3]; SwaUnit U, Un; int u = bid;
    float sk[4];
#pragma unroll
    for (int k4 = 0; k4 < 4; ++k4) sk[k4] = sinks[l * 16 + k4 * 4 + (tid >> 7)] * LOG2E;
    if (u < N_SWA_UNITS) { swa_decode(u, U); swa_load(U, l, zkv, cak, cav, tid, kr, vr); }
    while (u < N_SWA_UNITS) {
        int tq = tid; asm volatile("" : "+v"(tq));
        const int lane = tq & 63, wave = tq >> 6, g = wave >> 1, qh = wave & 1, h = lane >> 5;
        kv_store<3>(Ks, Vs, U.nk * 8, tq, kr, vr);
        const bool active = qh * 32 < U.nq; const int head = U.kvh * 4 + g, qi = qh * 32 + (lane & 31);
        bf16_t* qp = zq + (size_t)(U.qrow0 + qi) * 1024 + head * 64;
        bf16x8 qf[4];
        if (active) {
#pragma unroll
            for (int ds = 0; ds < 4; ++ds) qf[ds] = *(const bf16x8*)(qp + 16 * ds + 8 * h);
        }
        __syncthreads();
        const int un = u + G;
        if (un < N_SWA_UNITS) { int tl = tid; asm volatile("" : "+v"(tl)); swa_decode(un, Un); swa_load(Un, l, zkv, cak, cav, tl, kr, vr); }
        if (active) {
            const float slope = exp2f(-0.5f * (float)(head + 1));
            const float sink2 = U.kvh == 0 ? sk[0] : U.kvh == 1 ? sk[1] : U.kvh == 2 ? sk[2] : sk[3];
            if (U.nk == 192) attn_core<3, 2, true, true>(Ks, Vs, 6, qf, qp, 0.125f * LOG2E, slope * LOG2E, sink2, (192 - 64) + qi, lane);
            else attn_core<3, 2, true>(Ks, Vs, U.nk >> 5, qf, qp, 0.125f * LOG2E, slope * LOG2E, sink2, (U.nk - U.nq) + qi, lane);
        }
        __syncthreads();
        u = un; U = Un;
    }
}
struct XaUnit { int qrow0, h, b, nwaves; };
__device__ __forceinline__ void xa_decode(int unit, XaUnit& U) {
    if (unit < 256) { U.b = unit >> 5; U.h = (unit >> 3) & 3; U.qrow0 = U.b * SEQ + (unit & 7) * 256; U.nwaves = 8; }
    else { const int su = unit - 256; U.b = su >> 2; U.h = su & 3; U.qrow0 = MP + U.b * 32; U.nwaves = 1; }
}
__device__ __forceinline__ void xa_load(const XaUnit& U, int l, const bf16_t* mkv, const float* cmk, const float* cmv, int tid, bf16x8 (&kr)[4], bf16x8 (&vr)[4]) {
#pragma unroll
    for (int it = 0; it < 4; ++it) { const int idx = tid + it * 512, key = idx >> 3, ch = idx & 7;
        if (U.nwaves == 8) { const bf16_t* p = mkv + (size_t)(U.b * 256 + key) * 512 + U.h * 64 + ch * 8; kr[it] = *(const bf16x8*)p; vr[it] = *(const bf16x8*)(p + 256); }
        else { const size_t off = ((((size_t)l * DB + U.b) * 256 + key) * 4 + U.h) * 64 + ch * 8; kr[it] = cvt8(cmk + off); vr[it] = cvt8(cmv + off); } }
}
__device__ __forceinline__ void xa_phase(int l, LAS unsigned char* lds, const bf16_t* cq, bf16_t* co, const bf16_t* mkv, const float* cmk, const float* cmv, int tid, int bid, int G) {
    LAS unsigned char* Ks = lds; LAS unsigned char* Vs = lds + XA_VS_OFF;
    bf16x8 kr[4], vr[4]; XaUnit U, Un; int u = bid;
    if (u < N_XA_UNITS) { xa_decode(u, U); xa_load(U, l, mkv, cmk, cmv, tid, kr, vr); }
    while (u < N_XA_UNITS) {
        int tq = tid; asm volatile("" : "+v"(tq));
        const int lane = tq & 63, wave = tq >> 6, h = lane >> 5;
        kv_store<4>(Ks, Vs, 2048, tq, kr, vr);
        const bool active = wave < U.nwaves;
        const size_t off = (size_t)(U.qrow0 + wave * 32 + (lane & 31)) * 256 + U.h * 64;
        bf16x8 qf[4];
        if (active) {
#pragma unroll
            for (int ds = 0; ds < 4; ++ds) qf[ds] = *(const bf16x8*)(cq + off + 16 * ds + 8 * h);
        }
        __syncthreads();
        const int un = u + G;
        if (un < N_XA_UNITS) { int tl = tid; asm volatile("" : "+v"(tl)); xa_decode(un, Un); xa_load(Un, l, mkv, cmk, cmv, tl, kr, vr); }
        if (active) attn_core<4, 2, false>(Ks, Vs, 8, qf, co + off, 0.125f * LOG2E, 0.f, 0.f, 0, lane);
        __syncthreads();
        u = un; U = Un;
    }
}

__device__ __forceinline__ void conv_item(int wi, const bf16_t* zch, bf16_t* zcb, const bf16_t* zcc, const float* cw, const float* state, float* ocp, float* ocs, int tid) {
    const int r0 = wi * 64 + (tid >> 7) * 16, c = (tid & 127) * 8;
    float w0[8], w1[8], w2[8], um2[8], um1[8];
    { const f32x4 a = *(const f32x4*)(cw + c), b = *(const f32x4*)(cw + c + 4), d = *(const f32x4*)(cw + 1024 + c), e = *(const f32x4*)(cw + 1024 + c + 4), f = *(const f32x4*)(cw + 2048 + c), g = *(const f32x4*)(cw + 2048 + c + 4);
#pragma unroll
      for (int i = 0; i < 4; ++i) { w0[i] = a[i]; w0[4 + i] = b[i]; w1[i] = d[i]; w1[4 + i] = e[i]; w2[i] = f[i]; w2[4 + i] = g[i]; } }
    const bool is_p = r0 < MP; const int t0 = is_p ? (r0 & (SEQ - 1)) : ((r0 - MP) & 31); const int b = is_p ? (r0 >> 11) : ((r0 - MP) >> 5);
    {
        const int rh = r0 >= 2 ? r0 - 2 : 0;
        const u32x4 hm2 = *(const u32x4*)(zch + (size_t)rh * 1024 + c), hm1 = *(const u32x4*)(zch + (size_t)(rh + 1) * 1024 + c);
        const float* s = state + (size_t)(is_p ? 0 : b) * 2048 + c;
        const f32x4 sa = *(const f32x4*)s, sb = *(const f32x4*)(s + 4), sd = *(const f32x4*)(s + 1024), se = *(const f32x4*)(s + 1028);
        f32x4 h0, h1, g0, g1; unpack8(hm2, h0, h1); unpack8(hm1, g0, g1);
        const bool st = t0 == 0;
#pragma unroll
        for (int i = 0; i < 4; ++i) {
            um2[i] = st ? (is_p ? 0.f : sa[i]) : h0[i]; um2[4 + i] = st ? (is_p ? 0.f : sb[i]) : h1[i];
            um1[i] = st ? (is_p ? 0.f : sd[i]) : g0[i]; um1[4 + i] = st ? (is_p ? 0.f : se[i]) : g1[i];
        }
    }
#pragma unroll
    for (int tb = 0; tb < 16; tb += 8) {
        u32x4 uw[8], bw[8];
#pragma unroll
        for (int t = 0; t < 8; ++t) { const size_t off = (size_t)(r0 + tb + t) * 1024 + c; uw[t] = *(const u32x4*)(zch + off); bw[t] = *(const u32x4*)(zcb + off); }
#pragma unroll
        for (int t = 0; t < 8; ++t) {
            const size_t off = (size_t)(r0 + tb + t) * 1024 + c;
            f32x4 h0, h1, b0, b1;
            unpack8(uw[t], h0, h1); unpack8(bw[t], b0, b1);
            float u[8]; f32x4 r0v, r1v;
#pragma unroll
            for (int i = 0; i < 4; ++i) { u[i] = h0[i]; u[4 + i] = h1[i]; }
#pragma unroll
            for (int i = 0; i < 4; ++i) {
                r0v[i] = b0[i] * (um2[i] * w0[i] + um1[i] * w1[i] + u[i] * w2[i]);
                r1v[i] = b1[i] * (um2[4 + i] * w0[4 + i] + um1[4 + i] * w1[4 + i] + u[4 + i] * w2[4 + i]);
            }
            *(u32x4*)(zcb + off) = pack8(r0v, r1v);
#pragma unroll
            for (int i = 0; i < 8; ++i) { um2[i] = um1[i]; um1[i] = u[i]; }
        }
    }
    if (t0 + 15 == (is_p ? SEQ - 1 : DSQ - 1)) {
        float* o = (is_p ? ocp : ocs) + (size_t)b * 2048 + c;
        *(f32x4*)o = (f32x4){um2[0], um2[1], um2[2], um2[3]}; *(f32x4*)(o + 4) = (f32x4){um2[4], um2[5], um2[6], um2[7]};
        *(f32x4*)(o + 1024) = (f32x4){um1[0], um1[1], um1[2], um1[3]}; *(f32x4*)(o + 1028) = (f32x4){um1[4], um1[5], um1[6], um1[7]};
    }
}

__device__ __forceinline__ int win_perm(int n) {
    if (n < 1536 || n >= 4608) return n;
    if (n < 2560) { const int c = n - 1536; return 1536 + 256 * (c >> 7) + (c & 127); }
    if (n < 3584) return n + 1024;
    const int c = n - 3584; return 1536 + 256 * (c >> 7) + 128 + (c & 127);
}
template <bool WINPERM = false>
__device__ __forceinline__ void transpose_item(const float* W, int K, int N, const float* g, bf16_t* WT, LAS float* scr, int item, int lane) {
    const int nblk = N / 32, kb = item / nblk, nb = item % nblk, k0 = 64 * kb, n0 = 32 * nb; const int n0d = WINPERM ? win_perm(n0) : n0;
#pragma unroll
    for (int i = 0; i < 8; ++i) { const int kk = 8 * i + (lane >> 3), n4 = (lane & 7) * 4; f32x4 v = *(const f32x4*)(W + (size_t)(k0 + kk) * N + n0 + n4); if (g) v = v * g[k0 + kk];
        LAS float* d = scr + kk * 33 + n4; d[0] = v[0]; d[1] = v[1]; d[2] = v[2]; d[3] = v[3]; }
    asm volatile("s_waitcnt lgkmcnt(0)" ::: "memory");
    const int c = lane & 7;
#pragma unroll
    for (int j = 0; j < 4; ++j) { const int n = (lane >> 3) + 8 * j; const LAS float* s = scr + (8 * c) * 33 + n;
        u32x4 o; o.x = cvtpk(s[0 * 33], s[1 * 33]); o.y = cvtpk(s[2 * 33], s[3 * 33]); o.z = cvtpk(s[4 * 33], s[5 * 33]); o.w = cvtpk(s[6 * 33], s[7 * 33]);
        *(u32x4*)(WT + (size_t)(n0d + n) * K + k0 + 8 * c) = o; }
    asm volatile("s_waitcnt lgkmcnt(0)" ::: "memory");
}
__device__ __forceinline__ void row_prep(const float* src, float* xcopy, bf16_t* xb, float* ssq, bool norm, int lane) {
    const f32x4* xr = (const f32x4*)src + lane;
    f32x4 v[4]; float s = 0.f;
#pragma unroll
    for (int j = 0; j < 4; ++j) { v[j] = xr[64 * j]; s += (v[j][0] * v[j][0] + v[j][1] * v[j][1]) + (v[j][2] * v[j][2] + v[j][3] * v[j][3]); }
    s = wave_sum(s);
    const float sc = norm ? rsqrtf(s * (1.0f / DM) + EPS) : 1.0f;
    if (xcopy) {
#pragma unroll
        for (int j = 0; j < 4; ++j) ((f32x4*)xcopy + lane)[64 * j] = v[j];
    }
    u32x2* o8 = (u32x2*)xb + lane;
#pragma unroll
    for (int j = 0; j < 4; ++j) { u32x2 w; w.x = cvtpk(v[j][0] * sc, v[j][1] * sc); w.y = cvtpk(v[j][2] * sc, v[j][3] * sc); o8[64 * j] = w; }
    if (ssq && lane < 16) ssq[lane] = lane == 0 ? s : 0.f;
}

#define MFMA16(a, b, c) __builtin_amdgcn_mfma_f32_16x16x32_bf16((a), (b), (c), 0, 0, 0)
template <int KCH, class F>
__device__ __forceinline__ void sgemm_tile(LAS unsigned char* lds, const bf16_t* A, const bf16_t* Bt, int K, int row0, int col0, int tid, const F& f) {
    const int wave = tid >> 6, lane = tid & 63, fr = lane & 15, fq = lane >> 4;
    const int ks = K >> 3;
    const bf16_t* ap = A + (size_t)(row0 + fr) * K + wave * ks + fq * 16;
    const bf16_t* bp = Bt + (size_t)(col0 + fr) * K + wave * ks + fq * 16;
    const int r = tid >> 3, ch = (tid & 7) * 2;
    typename F::Pre pre = f.load(row0 + r, col0 + ch * 4);
    f32x4 acc[4][4];
#pragma unroll
    for (int m = 0; m < 4; ++m)
#pragma unroll
        for (int n = 0; n < 4; ++n) acc[m][n] = (f32x4){0.f, 0.f, 0.f, 0.f};
    if (KCH == 1) {
        bf16x8 af[4], bf[4];
#pragma unroll
        for (int m = 0; m < 4; ++m) af[m] = *(const bf16x8*)(ap + (size_t)m * 16 * K - fq * 8);
#pragma unroll
        for (int n = 0; n < 4; ++n) bf[n] = *(const bf16x8*)(bp + (size_t)n * 16 * K - fq * 8);
#pragma unroll
        for (int m = 0; m < 4; ++m)
#pragma unroll
            for (int n = 0; n < 4; ++n) acc[m][n] = MFMA16(bf[n], af[m], acc[m][n]);
    } else {
        for (int k = 0; k < ks; k += 128) {
            bf16x8 af[4][4], bf[4][4];
#pragma unroll
            for (int c = 0; c < 4; ++c) {
#pragma unroll
                for (int m = 0; m < 4; ++m) af[c][m] = *(const bf16x8*)(ap + (size_t)m * 16 * K + k + 64 * (c >> 1) + 8 * (c & 1));
#pragma unroll
                for (int n = 0; n < 4; ++n) bf[c][n] = *(const bf16x8*)(bp + (size_t)n * 16 * K + k + 64 * (c >> 1) + 8 * (c & 1));
            }
#pragma unroll
            for (int c = 0; c < 4; ++c)
#pragma unroll
                for (int m = 0; m < 4; ++m)
#pragma unroll
                    for (int n = 0; n < 4; ++n) acc[m][n] = MFMA16(bf[c][n], af[c][m], acc[m][n]);
        }
    }
    LAS float* part = (LAS float*)lds + wave * 4096;
#pragma unroll
    for (int m = 0; m < 4; ++m)
#pragma unroll
        for (int n = 0; n < 4; ++n) *(LAS f32x4*)(part + (m * 16 + fr) * 64 + (((n * 4 + fq) ^ fr) << 2)) = acc[m][n];
    __syncthreads();
    f32x4 v0 = (f32x4){0.f, 0.f, 0.f, 0.f}, v1 = v0;
#pragma unroll
    for (int w = 0; w < 8; ++w) { const LAS float* p = (const LAS float*)lds + w * 4096 + r * 64;
        v0 += *(const LAS f32x4*)(p + ((ch ^ (r & 15)) << 2)); v1 += *(const LAS f32x4*)(p + (((ch + 1) ^ (r & 15)) << 2)); }
    f.apply(row0 + r, col0 + ch * 4, v0, v1, pre);
    __syncthreads();
}
struct SGate1 { bf16_t* zga; struct Pre { u32x4 g; };
    __device__ __forceinline__ Pre load(int row, int col) const { Pre p; p.g = *(const u32x4*)(zga + (size_t)row * 1024 + col); return p; }
    __device__ __forceinline__ void apply(int row, int col, f32x4 v0, f32x4 v1, const Pre& pr) const {
        f32x4 g0, g1; unpack8(pr.g, g0, g1);
#pragma unroll
        for (int e = 0; e < 4; ++e) { v0[e] *= sigmoidf_(g0[e]); v1[e] *= sigmoidf_(g1[e]); }
        *(u32x4*)(zga + (size_t)row * 1024 + col) = pack8(v0, v1); } };
struct SGate2 { bf16_t* zga; const bf16_t* zgb; struct Pre { u32x4 t, g; };
    __device__ __forceinline__ Pre load(int row, int col) const { const size_t off = (size_t)row * 1024 + col; Pre p; p.t = *(const u32x4*)(zga + off); p.g = *(const u32x4*)(zgb + off); return p; }
    __device__ __forceinline__ void apply(int row, int col, f32x4 v0, f32x4 v1, const Pre& pr) const {
        f32x4 t0, t1, g0, g1; unpack8(pr.t, t0, t1); unpack8(pr.g, g0, g1);
#pragma unroll
        for (int e = 0; e < 4; ++e) { v0[e] = t0[e] + v0[e] * sigmoidf_(g0[e]); v1[e] = t1[e] + v1[e] * sigmoidf_(g1[e]); }
        *(u32x4*)(zga + (size_t)row * 1024 + col) = pack8(v0, v1); } };
struct SResid { float* x; bf16_t* xb; float* ssq; const float* ssq_in; struct Pre { u32x4 w; float rs2; };
    __device__ __forceinline__ Pre load(int row, int col) const { Pre p; p.w = *(const u32x4*)(xb + (size_t)row * 1024 + col);
        p.rs2 = 1.f; if (ssq_in) { const float r_ = row_rstd(ssq_in, row); p.rs2 = r_ * r_; } return p; }
    __device__ __forceinline__ void apply(int row, int col, f32x4 v0, f32x4 v1, const Pre& pr) const {
        const size_t off = (size_t)row * 1024 + col;
        f32x4 x0, x1; unpack8(pr.w, x0, x1);
        v0 = v0 * pr.rs2 + x0; v1 = v1 * pr.rs2 + x1;
        *(u32x4*)(xb + off) = pack8(v0, v1);
        float sq = (v0[0] * v0[0] + v0[1] * v0[1]) + (v0[2] * v0[2] + v0[3] * v0[3]) + (v1[0] * v1[0] + v1[1] * v1[1]) + (v1[2] * v1[2] + v1[3] * v1[3]);
        sq += __shfl_xor(sq, 1); sq += __shfl_xor(sq, 2); sq += __shfl_xor(sq, 4);
        if ((col & 63) == 0) ssq[(size_t)row * 16 + (col >> 6)] = sq; } };
struct SUp { bf16_t* o; const float* ssq; struct Pre { float rs; };
    __device__ __forceinline__ Pre load(int row, int col) const { Pre p; p.rs = row_rstd(ssq, row); return p; }
    __device__ __forceinline__ void apply(int row, int col, f32x4 v0, f32x4 v1, const Pre& pr) const {
        const float rs = pr.rs;
#pragma unroll
        for (int e = 0; e < 4; ++e) { const float a = fmaxf(v0[e] * rs, 0.f), b = fmaxf(v1[e] * rs, 0.f); v0[e] = a * a; v1[e] = b * b; }
        *(u32x4*)(o + (size_t)row * FF + col) = pack8(v0, v1); } };

__device__ __forceinline__ void sgemm_tile_gate2(LAS unsigned char* lds, const bf16_t* A0, const bf16_t* B0, const bf16_t* A1, const bf16_t* B1, int K, int row0, int col0, int tid,
                                                 bf16_t* zga, const bf16_t* zgb) {
    const int wave = tid >> 6, lane = tid & 63, fr = lane & 15, fq = lane >> 4;
    const int ks = K >> 2, wq = wave & 3;
    const bf16_t* A = wave < 4 ? A0 : A1; const bf16_t* Bt = wave < 4 ? B0 : B1;
    const bf16_t* ap = A + (size_t)(row0 + fr) * K + wq * ks + fq * 16;
    const bf16_t* bp = Bt + (size_t)(col0 + fr) * K + wq * ks + fq * 16;
    const int r = tid >> 3, ch = (tid & 7) * 2;
    const size_t goff = (size_t)(row0 + r) * 1024 + col0 + ch * 4;
    const u32x4 gaw = *(const u32x4*)(zga + goff), gbw = *(const u32x4*)(zgb + goff);
    f32x4 acc[4][4];
#pragma unroll
    for (int m = 0; m < 4; ++m)
#pragma unroll
        for (int n = 0; n < 4; ++n) acc[m][n] = (f32x4){0.f, 0.f, 0.f, 0.f};
    for (int k = 0; k < ks; k += 128) {
        bf16x8 af[4][4], bf[4][4];
#pragma unroll
        for (int c = 0; c < 4; ++c) {
#pragma unroll
            for (int m = 0; m < 4; ++m) af[c][m] = *(const bf16x8*)(ap + (size_t)m * 16 * K + k + 64 * (c >> 1) + 8 * (c & 1));
#pragma unroll
            for (int n = 0; n < 4; ++n) bf[c][n] = *(const bf16x8*)(bp + (size_t)n * 16 * K + k + 64 * (c >> 1) + 8 * (c & 1));
        }
#pragma unroll
        for (int c = 0; c < 4; ++c)
#pragma unroll
            for (int m = 0; m < 4; ++m)
#pragma unroll
                for (int n = 0; n < 4; ++n) acc[m][n] = MFMA16(bf[c][n], af[c][m], acc[m][n]);
    }
    LAS float* part = (LAS float*)lds + wave * 4096;
#pragma unroll
    for (int m = 0; m < 4; ++m)
#pragma unroll
        for (int n = 0; n < 4; ++n) *(LAS f32x4*)(part + (m * 16 + fr) * 64 + (((n * 4 + fq) ^ fr) << 2)) = acc[m][n];
    __syncthreads();
    f32x4 a0 = (f32x4){0.f, 0.f, 0.f, 0.f}, a1 = a0, b0 = a0, b1 = a0;
#pragma unroll
    for (int w = 0; w < 4; ++w) { const LAS float* p = (const LAS float*)lds + w * 4096 + r * 64;
        a0 += *(const LAS f32x4*)(p + ((ch ^ (r & 15)) << 2)); a1 += *(const LAS f32x4*)(p + (((ch + 1) ^ (r & 15)) << 2));
        b0 += *(const LAS f32x4*)(p + 4 * 4096 + ((ch ^ (r & 15)) << 2)); b1 += *(const LAS f32x4*)(p + 4 * 4096 + (((ch + 1) ^ (r & 15)) << 2)); }
    f32x4 ga0, ga1, gb0, gb1; unpack8(gaw, ga0, ga1); unpack8(gbw, gb0, gb1);
#pragma unroll
    for (int e = 0; e < 4; ++e) { a0[e] = a0[e] * sigmoidf_(ga0[e]) + b0[e] * sigmoidf_(gb0[e]); a1[e] = a1[e] * sigmoidf_(ga1[e]) + b1[e] * sigmoidf_(gb1[e]); }
    *(u32x4*)(zga + goff) = pack8(a0, a1);
    __syncthreads();
}

__device__ __forceinline__ void row_prep2(const float* srcA, float* xcA, bf16_t* xbA, float* ssqA, bool normA, const float* srcB, float* xcB, bf16_t* xbB, float* ssqB, bool normB, bool hasB, int lane) {
    const f32x4* pa = (const f32x4*)srcA + lane; const f32x4* pb = (const f32x4*)srcB + lane;
    f32x4 va[4], vb[4]; float sa = 0.f, sb = 0.f;
#pragma unroll
    for (int j = 0; j < 4; ++j) { va[j] = pa[64 * j]; vb[j] = pb[64 * j]; }
#pragma unroll
    for (int j = 0; j < 4; ++j) { sa += (va[j][0] * va[j][0] + va[j][1] * va[j][1]) + (va[j][2] * va[j][2] + va[j][3] * va[j][3]);
                                  sb += (vb[j][0] * vb[j][0] + vb[j][1] * vb[j][1]) + (vb[j][2] * vb[j][2] + vb[j][3] * vb[j][3]); }
#pragma unroll
    for (int o = 1; o < 64; o <<= 1) { sa += __shfl_xor(sa, o); sb += __shfl_xor(sb, o); }
    const float ca = normA ? rsqrtf(sa * (1.0f / DM) + EPS) : 1.0f, cb = normB ? rsqrtf(sb * (1.0f / DM) + EPS) : 1.0f;
    u32x2* oa = (u32x2*)xbA + lane; u32x2* ob = (u32x2*)xbB + lane;
#pragma unroll
    for (int j = 0; j < 4; ++j) { u32x2 w; w.x = cvtpk(va[j][0] * ca, va[j][1] * ca); w.y = cvtpk(va[j][2] * ca, va[j][3] * ca); oa[64 * j] = w; }
    if (xcA) {
#pragma unroll
        for (int j = 0; j < 4; ++j) ((f32x4*)xcA + lane)[64 * j] = va[j];
    }
    if (ssqA && lane < 16) ssqA[lane] = lane == 0 ? sa : 0.f;
    if (hasB) {
        if (xcB) {
#pragma unroll
            for (int j = 0; j < 4; ++j) ((f32x4*)xcB + lane)[64 * j] = vb[j];
        }
#pragma unroll
        for (int j = 0; j < 4; ++j) { u32x2 w; w.x = cvtpk(vb[j][0] * cb, vb[j][1] * cb); w.y = cvtpk(vb[j][2] * cb, vb[j][3] * cb); ob[64 * j] = w; }
        if (ssqB && lane < 16) ssqB[lane] = lane == 0 ? sb : 0.f;
    }
}
#define XB_TMO      128
#define XB_XCNT(j)  (256  + 64 * (j))
#define XB_XSUB(j)  (1280 + 64 * (j))
#define XB_XGEN(j)  (2304 + 64 * (j))
#define XB_TOP      3328
#define XB_TOPGEN   3392
#define XCD_BAR_WORDS 3456
#define XB_SPIN_CAP (1u << 18)

__device__ __forceinline__ unsigned xb_ld(unsigned* p)              { return __hip_atomic_load(p, __ATOMIC_RELAXED, __HIP_MEMORY_SCOPE_AGENT); }
__device__ __forceinline__ unsigned xb_add(unsigned* p, unsigned v) { return __hip_atomic_fetch_add(p, v, __ATOMIC_RELAXED, __HIP_MEMORY_SCOPE_AGENT); }
__device__ __forceinline__ unsigned xb_xcc_id() { return (unsigned)__builtin_amdgcn_s_getreg((3 << 11) | 20) & 0xFu; }
#define XB_SPIN(cond, bar) do { unsigned _sp = 0; while (cond) { __builtin_amdgcn_s_sleep(1); \
    if ((++_sp & 255u) == 0u) { if (xb_ld(&(bar)[XB_TMO])) break; if (_sp > XB_SPIN_CAP) { atomicAdd(&(bar)[XB_TMO], 1u); break; } } } } while (0)

struct XcdBarrier {
    unsigned* bar; unsigned x;
    volatile LAS unsigned* st;
};

__device__ __forceinline__ XcdBarrier xcd_barrier_post(unsigned* bar, volatile LAS unsigned* st) {
    XcdBarrier b; b.bar = bar; b.x = xb_xcc_id(); b.st = st;
    if (threadIdx.x == 0) (void)xb_add(&bar[XB_XCNT(b.x)], 1u);
    return b;
}
__device__ __forceinline__ void xcd_barrier_complete(unsigned* bar, unsigned x, unsigned& nloc, unsigned& nx) {
    const unsigned G = gridDim.x * gridDim.y * gridDim.z;
    unsigned sum, cnt, mine, sp = 0u;
    for (;;) {
        sum = 0u; cnt = 0u; mine = 0u;
#pragma nounroll
        for (unsigned j = 0; j < 16; ++j) { const unsigned c = xb_ld(&bar[XB_XCNT(j)]); sum += c; cnt += (c > 0u) ? 1u : 0u; mine = (j == x) ? c : mine; }
        if (sum == G) break;
        __builtin_amdgcn_s_sleep(1);
        if ((++sp & 255u) == 0u) { if (xb_ld(&bar[XB_TMO])) break; if (sp > XB_SPIN_CAP) { atomicAdd(&bar[XB_TMO], 1u); break; } }
    }
    nloc = mine > 0u ? mine : 1u; nx = cnt > 0u ? cnt : 1u;
}

__device__ __forceinline__ void xcd_barrier(const XcdBarrier& b) {
    asm volatile("s_waitcnt vmcnt(0)" ::: "memory");
    __syncthreads();
    if (threadIdx.x == 0) {
        unsigned* bar = b.bar; const unsigned bx = xb_xcc_id();
        __builtin_amdgcn_s_waitcnt(0);
        unsigned nloc = b.st[0], nx = b.st[1];
        if (nloc == 0u) { xcd_barrier_complete(bar, bx, nloc, nx); b.st[0] = nloc; b.st[1] = nx; }
        const unsigned old = xb_add(&bar[XB_XSUB(bx)], 1u);
        const unsigned gen = old / nloc;
        if (old + 1u == (gen + 1u) * nloc) {
            __builtin_amdgcn_fence(__ATOMIC_RELEASE, "agent");
            asm volatile("s_waitcnt vmcnt(0)" ::: "memory");
            const unsigned og = xb_add(&bar[XB_TOP], 1u);
            const unsigned tg = og / nx;
            if (og + 1u == (tg + 1u) * nx) xb_add(&bar[XB_TOPGEN], 1u);
            else XB_SPIN(xb_ld(&bar[XB_TOPGEN]) == tg, bar);
            __builtin_amdgcn_fence(__ATOMIC_ACQUIRE, "agent");
            xb_add(&bar[XB_XGEN(bx)], 1u);
            asm volatile("s_waitcnt vmcnt(0)" ::: "memory");
        } else {
            XB_SPIN(xb_ld(&bar[XB_XGEN(bx)]) == gen, bar);
            __builtin_amdgcn_fence(__ATOMIC_ACQUIRE, "agent");
            asm volatile("s_waitcnt vmcnt(0)" ::: "memory");
        }
    }
    __syncthreads();
}

constexpr int RING_BYTES = 131072, LDS_BYTES = 132096;
struct Args { const float* in[24]; float* out; unsigned char* ws; };

#define GEMM_PHASE(EpiT, E, A_, Bt_, M_, N_, K_, CIDX) do { int k_ = (K_); asm volatile("" : "+s"(k_)); pg8::Gemm g_{(const pg8::bf16_t*)(A_), (const pg8::bf16_t*)(Bt_), (M_), (N_), k_}; pg8::StaticOrder S_; S_.init((M_), (N_), G, (CIDX)); \
    pg8::gemm_phase<EpiT, pg8::StaticOrder, true, true>(lds, g_, S_, (E)); } while (0)

#define STILES(NT, LGN, A_, Bt_, K_, F_) STILES_(4, NT, LGN, A_, Bt_, K_, F_)
#define STILES_(KCH, NT, LGN, A_, Bt_, K_, F_) do { int ts_ = threadIdx.x, kk_ = (K_); asm volatile("" : "+v"(ts_)); asm volatile("" : "+s"(kk_)); \
    for (int t_ = bid; t_ < (NT); t_ += G) sgemm_tile<KCH>(lds, (A_), (Bt_), kk_, MP + (t_ >> (LGN)) * 64, (t_ & ((1 << (LGN)) - 1)) * 64, ts_, (F_)); } while (0)

constexpr int I_IN = 16 * (NIN / 32), I_SQ = 16 * 32, I_CQ = 16 * 8, I_CKV = 16 * 16, I_CO = 4 * 32, I_UP = 16 * 128, I_DN = 64 * 32;
constexpr int I_LAYER = I_IN + 3 * I_SQ + I_CQ + I_CKV + I_CO + I_UP + I_DN;
__device__ __forceinline__ void convert_weights(const Args& a, bf16_t* WT, LAS unsigned char* lds, int l, int nitems, int gw, int NGW, int wave, int lane) {
    LAS float* scr = (LAS float*)(lds + wave * 16384);
    bf16_t* wl = WT + (size_t)l * W_LAYER;
    for (int it = gw; it < nitems; it += NGW) {
        int r = it; { int ln = lane; asm volatile("" : "+v"(ln)); lane = ln; }
        if (r < I_IN) { transpose_item<true>(a.in[9] + (size_t)l * DM * NIN, DM, NIN, a.in[8] + l * DM, wl + WO_IN, scr, r, lane); continue; } r -= I_IN;
        if (r < I_SQ) { transpose_item(a.in[12] + (size_t)l * DM * DM, DM, DM, nullptr, wl + WO_AO, scr, r, lane); continue; } r -= I_SQ;
        if (r < I_SQ) { transpose_item(a.in[13] + (size_t)l * DM * DM, DM, DM, nullptr, wl + WO_CV, scr, r, lane); continue; } r -= I_SQ;
        if (r < I_SQ) { transpose_item(a.in[14] + (size_t)l * DM * DM, DM, DM, nullptr, wl + WO_MIX, scr, r, lane); continue; } r -= I_SQ;
        if (r < I_CQ) { transpose_item(a.in[17] + (size_t)l * DM * 256, DM, 256, a.in[15] + l * DM, wl + WO_CQ, scr, r, lane); continue; } r -= I_CQ;
        if (r < I_CO) { transpose_item(a.in[19] + (size_t)l * 256 * DM, 256, DM, nullptr, wl + WO_CO, scr, r, lane); continue; } r -= I_CO;
        if (r < I_UP) { transpose_item(a.in[21] + (size_t)l * DM * FF, DM, FF, a.in[20] + l * DM, wl + WO_UP, scr, r, lane); continue; } r -= I_UP;
        if (r < I_DN) { transpose_item(a.in[22] + (size_t)l * FF * DM, FF, DM, nullptr, wl + WO_DN, scr, r, lane); continue; } r -= I_DN;
        const int ll = r / I_CKV; r -= ll * I_CKV;
        transpose_item(a.in[18] + (size_t)ll * DM * 512, DM, 512, a.in[16] + ll * DM, WT + (size_t)ll * W_LAYER + WO_CKV, scr, r, lane);
    }
}

__global__ void __launch_bounds__(512, 2) fwd_mega(Args a) {
    extern __shared__ __attribute__((aligned(16))) unsigned char lds_raw[];
    cg::grid_group grid = cg::this_grid();
    LAS unsigned char* lds = (LAS unsigned char*)lds_raw;
    const int tid = threadIdx.x, lane = tid & 63, wave = __builtin_amdgcn_readfirstlane(tid >> 6);
    const int G = gridDim.x, bid = blockIdx.x;
    unsigned char* ws = a.ws; float* out = a.out;
    bf16_t* XB = (bf16_t*)(ws + WS_XB); float* SSQ = (float*)(ws + WS_SSQ); bf16_t* MEMN = (bf16_t*)(ws + WS_MEMN); bf16_t* MKV = (bf16_t*)(ws + WS_MKV);
    bf16_t* CQ = (bf16_t*)(ws + WS_CQ); bf16_t* CO = (bf16_t*)(ws + WS_CO);
    bf16_t* ZQ = (bf16_t*)(ws + WS_ZQ); bf16_t* ZKV = (bf16_t*)(ws + WS_ZKV); bf16_t* ZCH = (bf16_t*)(ws + WS_ZCH); bf16_t* ZCB = (bf16_t*)(ws + WS_ZCB);
    bf16_t* ZCC = (bf16_t*)(ws + WS_ZCC); bf16_t* ZGA = (bf16_t*)(ws + WS_ZGA); bf16_t* ZGB = (bf16_t*)(ws + WS_ZGB); bf16_t* HID = (bf16_t*)(ws + WS_HID);
    bf16_t* WT = (bf16_t*)(ws + WS_W);
    float* X = out + O_Y;
    volatile LAS unsigned* MISC = (volatile LAS unsigned*)(lds + RING_BYTES);
    if (tid < 64) MISC[tid] = 0u;
    __syncthreads();
    XcdBarrier bar = xcd_barrier_post((unsigned*)ws + 1024, MISC + 8);
#define SEAM() xcd_barrier(bar)

    {
        const int gw = bid * 8 + wave, NGW = G * 8;
        convert_weights(a, WT, lds, 0, I_LAYER + 3 * I_CKV, gw, NGW, wave, lane);
        for (int m = gw; m < MT + 2048; m += 2 * NGW) {
            const int mB = m + NGW; const bool hasB = mB < MT + 2048; const int mb = hasB ? mB : m;
            const float* srcA = m < MP ? a.in[0] + (size_t)m * DM : m < MT ? a.in[1] + (size_t)(m - MP) * DM : a.in[2] + (size_t)(m - MT) * DM;
            const float* srcB = mb < MP ? a.in[0] + (size_t)mb * DM : mb < MT ? a.in[1] + (size_t)(mb - MP) * DM : a.in[2] + (size_t)(mb - MT) * DM;
            bf16_t* dA = m < MT ? XB + (size_t)m * DM : MEMN + (size_t)(m - MT) * DM; bf16_t* dB = mb < MT ? XB + (size_t)mb * DM : MEMN + (size_t)(mb - MT) * DM;
            row_prep2(srcA, nullptr, dA, m < MT ? SSQ + (size_t)m * 16 : nullptr, m >= MT,
                      srcB, nullptr, dB, mb < MT ? SSQ + (size_t)mb * 16 : nullptr, mb >= MT, hasB, lane);
        }
    }
    if (a.ws == nullptr) grid.sync();
    SEAM();

    float* SSQ1 = (float*)(ws + WS_ZGA - 2 * MiB);
    int si = 0;
#define SQ(i_) ((i_) ? SSQ1 : SSQ)
    for (int l = 0; l < DEPTH; ++l) {
        const bf16_t* wl = WT + (size_t)l * W_LAYER;
        {
            EpiZ E{ZQ, ZKV, ZCH, ZCB, ZCC, ZGA, ZGB, SQ(si), out + O_KP + (size_t)l * NB * 128 * 256, out + O_VP + (size_t)l * NB * 128 * 256,
                   out + O_KS + (size_t)l * DB * DSQ * 256, out + O_VS + (size_t)l * DB * DSQ * 256};
            { int c1 = bid; asm volatile("" : "+s"(c1)); GEMM_PHASE(EpiZ, E, XB, wl + WO_IN, MT, NIN, DM, c1); }
            if (l == 0) {
                for (int ll = 0; ll < DEPTH; ++ll) {
                    EpiMemKV EM{MKV + (size_t)ll * 2048 * 512, out + O_MKP + (size_t)ll * 2048 * 256, out + O_MVP + (size_t)ll * 2048 * 256};
                    GEMM_PHASE(EpiMemKV, EM, MEMN, WT + (size_t)ll * W_LAYER + WO_CKV, 2048, 512, DM, (bid + G - 192 - 16 * ll) % G);
                }
            }
        }
        SEAM();
        {
            int t2 = threadIdx.x; asm volatile("" : "+v"(t2));
            for (int half = 0; half < 2; ++half) {
                if (((half ^ bid) & 1) == 0) swa_phase(l, lds, ZQ, ZKV, a.in[3], a.in[4], a.in[11], t2, bid, G);
                else {
                    for (int wi = G - 1 - bid; wi < MT / 64; wi += G)
                        conv_item(wi, ZCH, ZCB, ZCC, a.in[10] + (size_t)l * 3 * DM, a.in[5] + (size_t)l * DB * 2 * DM, out + O_CP + (size_t)l * NB * 2 * DM, out + O_CS + (size_t)l * DB * 2 * DM, t2);
                }
            }
        }
        SEAM();
        {
            { int k_ = DM; asm volatile("" : "+s"(k_));
              pg8::Gemm g_{(const pg8::bf16_t*)ZQ, (const pg8::bf16_t*)(wl + WO_AO), MP, DM, k_, (const pg8::bf16_t*)ZCB, (const pg8::bf16_t*)(wl + WO_CV)};
              pg8::PairOrder S_; S_.init(MP, DM, G, bid); EpiGatePair EP{ZGA, ZGB};
              pg8::gemm_phase<EpiGatePair, pg8::PairOrder, true, true>(lds, g_, S_, EP); }
            { int ts_ = threadIdx.x, kk_ = DM; asm volatile("" : "+v"(ts_)); asm volatile("" : "+s"(kk_));
              for (int t_ = bid; t_ < 256; t_ += G) sgemm_tile_gate2(lds, ZQ, wl + WO_AO, ZCB, wl + WO_CV, kk_, MP + (t_ >> 4) * 64, (t_ & 15) * 64, ts_, ZGA, ZGB); }
        }
        SEAM();
        {
            EpiResidT<false> E{X, XB, SQ(si ^ 1), nullptr}; GEMM_PHASE(EpiResidT<false>, E, ZGA, wl + WO_MIX, MP, DM, DM, bid); SResid F{X, XB, SQ(si ^ 1), nullptr}; STILES(256, 4, ZGA, wl + WO_MIX, DM, F); si ^= 1;
        }
        SEAM();
        {
            EpiScale<0> E{CQ, 256, SQ(si)}; GEMM_PHASE(EpiScale<0>, E, XB, wl + WO_CQ, MT, 256, DM, bid);
            if (bid >= 68 && l + 1 < DEPTH) convert_weights(a, WT, lds, l + 1, I_LAYER - I_CKV, (bid - 68) * 8 + wave, (G - 68) * 8, wave, lane);
        }
        SEAM();
        {
            int t6 = threadIdx.x; asm volatile("" : "+v"(t6));
            xa_phase(l, lds, CQ, CO, MKV + (size_t)l * 2048 * 512, a.in[6], a.in[7], t6, bid, G);
        }
        SEAM();
        {
            EpiResidT<false> E{X, XB, SQ(si ^ 1), nullptr}; GEMM_PHASE(EpiResidT<false>, E, CO, wl + WO_CO, MP, DM, 256, bid); SResid F{X, XB, SQ(si ^ 1), nullptr}; STILES_(1, 256, 4, CO, wl + WO_CO, 256, F); si ^= 1;
        }
        SEAM();
        {
            EpiRelu2 E{HID, FF}; GEMM_PHASE(EpiRelu2, E, XB, wl + WO_UP, MT, FF, DM, bid);
        }
        SEAM();
        {
            EpiResidT<true> E{X, XB, SQ(si ^ 1), SQ(si)}; GEMM_PHASE(EpiResidT<true>, E, HID, wl + WO_DN, MP, DM, FF, bid); SResid F{X, XB, SQ(si ^ 1), SQ(si)}; STILES(256, 4, HID, wl + WO_DN, FF, F); si ^= 1;
        }
        SEAM();
    }
    {
        const float* gf = a.in[23];
        int tf = threadIdx.x; asm volatile("" : "+v"(tf)); const int lane = tf & 63, wave = tf >> 6;
        const f32x4* gr = (const f32x4*)gf + lane * 4;
        const f32x4 h0 = gr[0], h1 = gr[1], h2 = gr[2], h3 = gr[3];
        for (int m = bid * 8 + wave; m < MT; m += G * 16) {
            const int m2 = m + G * 8; const bool has2 = m2 < MT; const int mb = has2 ? m2 : m;
            const float rsa = row_rstd(SQ(si), m), rsb = row_rstd(SQ(si), mb);
            const u32x4* pa = (const u32x4*)(XB + (size_t)m * DM) + lane * 2; const u32x4* pb = (const u32x4*)(XB + (size_t)mb * DM) + lane * 2;
            const u32x4 wa0 = pa[0], wa1 = pa[1], wb0 = pb[0], wb1 = pb[1];
            f32x4 a0, a1, a2, a3, b0, b1, b2, b3; unpack8(wa0, a0, a1); unpack8(wa1, a2, a3); unpack8(wb0, b0, b1); unpack8(wb1, b2, b3);
            f32x4* ya = (f32x4*)(X + (size_t)m * DM) + lane * 4; f32x4* yb = (f32x4*)(X + (size_t)mb * DM) + lane * 4;
            ya[0] = a0 * rsa * h0; ya[1] = a1 * rsa * h1; ya[2] = a2 * rsa * h2; ya[3] = a3 * rsa * h3;
            if (has2) { yb[0] = b0 * rsb * h0; yb[1] = b1 * rsb * h1; yb[2] = b2 * rsb * h2; yb[3] = b3 * rsb * h3; }
        }
    }
}

extern "C" void kernel_launch(void* const* d_in, const int* in_sizes, int n_in, void* d_out, int out_size, void* d_ws, size_t ws_size, hipStream_t stream) {
    static int grid = 0;
    if (grid == 0) {
        int dev = 0, cus = 0, per_cu = 0;
        hipGetDevice(&dev);
        hipDeviceGetAttribute(&cus, hipDeviceAttributeMultiprocessorCount, dev);
        hipFuncSetAttribute((const void*)fwd_mega, hipFuncAttributeMaxDynamicSharedMemorySize, LDS_BYTES);
        hipOccupancyMaxActiveBlocksPerMultiprocessor(&per_cu, (const void*)fwd_mega, 512, LDS_BYTES);
        if (per_cu < 1) per_cu = 1;
        grid = cus * per_cu;
        if (ws_size < WS_END) fprintf(stderr, "kernel_launch: workspace too small: %zu < %zu\n", ws_size, (size_t)WS_END);
        (void)hipGetLastError();
    }
    hipMemsetAsync(d_ws, 0, 65536, stream);
    Args a{};
    for (int i = 0; i < 24; ++i) a.in[i] = (const float*)d_in[i];
    a.out = (float*)d_out; a.ws = (unsigned char*)d_ws;
    void* args[] = {&a};
    hipError_t e = hipLaunchCooperativeKernel((const void*)fwd_mega, dim3(grid), dim3(512), args, LDS_BYTES, stream);
    if (e != hipSuccess) fprintf(stderr, "cooperative launch failed: %s (grid %d)\n", hipGetErrorString(e), grid);
}
```
